# Optimizing an MI355X kernel written in HIP

```python
import math
import jax, jax.numpy as jnp
from jax import lax
import numpy as np

D_MODEL = 1024
BATCH = 8
SEQ = 2048
DEPTH = 2

CTX_LEN = 256
GRID_W = 64
EPS = 1e-6

MLA_HEADS = 8
MLA_NOPE = 64
MLA_ROPE = 32
MLA_V = 64
MLA_Q_RANK = 256
MLA_KV_RANK = 128
ROPE_BASE = 10000.0
Q_BLOCK = 128
ATTN_SCALE = (MLA_NOPE + MLA_ROPE) ** -0.5

SSM_HEADS = 8
SSM_HEADDIM = 64
SSM_INNER = SSM_HEADS * SSM_HEADDIM
SSM_GROUPS = 2
SSM_STATE = 128
SSM_CONV = 5
SSM_CHUNK = 128
XBC_DIM = SSM_INNER + 2 * SSM_GROUPS * SSM_STATE

GM_GROUPS = 8
GM_WIDTH = 512
GM_GDIM = GM_WIDTH // GM_GROUPS
GM_CHUNK = 128

D_FF = 2816
N_BRANCH = 3
N_MOD = 9

KV_SIZES = (MLA_KV_RANK, MLA_ROPE, XBC_DIM, SSM_HEADS, SSM_HEADS)
Q_SIZES = (MLA_Q_RANK, SSM_INNER, 2 * GM_WIDTH, N_BRANCH * D_MODEL)
KV_SIDE = MLA_KV_RANK + MLA_ROPE + XBC_DIM + 2 * SSM_HEADS
D_IN = KV_SIDE + MLA_Q_RANK + SSM_INNER + 2 * GM_WIDTH + N_BRANCH * D_MODEL

kernel_name = "hybrid_mla_ssd_gmlp_prefix_dit"


def _split(t, sizes):
    offs = []
    acc = 0
    for s in sizes[:-1]:
        acc += s
        offs.append(acc)
    return jnp.split(t, offs, axis=-1)


def rmsnorm(x, g):
    xf = x.astype(jnp.float32)
    y = xf * lax.rsqrt(jnp.mean(xf * xf, axis=-1, keepdims=True) + EPS)
    return (y * g.astype(jnp.float32)).astype(x.dtype)


def layernorm(x, g):
    xf = x.astype(jnp.float32)
    xf = xf - jnp.mean(xf, axis=-1, keepdims=True)
    y = xf * lax.rsqrt(jnp.mean(xf * xf, axis=-1, keepdims=True) + EPS)
    return (y * g.astype(jnp.float32)).astype(x.dtype)


def pre(h, g, shift, scale):
    return rmsnorm(h, g) * (1.0 + scale) + shift


def swiglu(h, w_i, w_o):
    gate, up = jnp.split(h @ w_i, 2, axis=-1)
    return (jax.nn.silu(gate) * up) @ w_o


def axial_rope_tables(rows):
    row = jnp.repeat(jnp.arange(rows, dtype=jnp.float32), GRID_W)
    col = jnp.tile(jnp.arange(GRID_W, dtype=jnp.float32), rows)
    n_freq = MLA_ROPE // 4
    inv = jnp.power(ROPE_BASE, -jnp.arange(n_freq, dtype=jnp.float32) / n_freq)
    ang = jnp.concatenate([row[:, None] * inv, col[:, None] * inv], axis=-1)
    return jnp.cos(ang), jnp.sin(ang)


def apply_rope(x, cos, sin):
    half = x.shape[-1] // 2
    x1, x2 = x[..., :half], x[..., half:]
    return jnp.concatenate([x1 * cos - x2 * sin, x1 * sin + x2 * cos], axis=-1).astype(x.dtype)


def mla_keys(kv_lat, p):
    B, L, _ = kv_lat.shape
    kv = (rmsnorm(kv_lat, p["mla_kv_norm"]) @ p["mla_w_ukv"]).reshape(B, L, MLA_HEADS, MLA_NOPE + MLA_V)
    return kv[..., :MLA_NOPE], kv[..., MLA_NOPE:]


def mla_queries(q_lat, p):
    B, L, _ = q_lat.shape
    q = (rmsnorm(q_lat, p["mla_q_norm"]) @ p["mla_w_uq"]).reshape(B, L, MLA_HEADS, MLA_NOPE + MLA_ROPE)
    return q[..., :MLA_NOPE], q[..., MLA_NOPE:]


def block_attention(q_nope, q_rope, k_nope, k_rope, v):
    B, Lq, H, _ = q_nope.shape
    nb = Lq // Q_BLOCK

    def blocks(t):
        return jnp.moveaxis(t.reshape((B, nb, Q_BLOCK) + t.shape[2:]), 1, 0)

    def one(qs):
        qn, qr = qs
        s = jnp.einsum('bqhd,bkhd->bhqk', qn, k_nope) + jnp.einsum('bqhr,bkr->bhqk', qr, k_rope)
        pr = jax.nn.softmax(s.astype(jnp.float32) * ATTN_SCALE, axis=-1).astype(v.dtype)
        return jnp.einsum('bhqk,bkhd->bqhd', pr, v)

    o = lax.map(one, (blocks(q_nope), blocks(q_rope)))
    return jnp.moveaxis(o, 0, 1).reshape(B, Lq, H * MLA_V)


def dwconv_centred(x, w, b):
    pad = SSM_CONV // 2
    out = lax.conv_general_dilated(x, w.T[:, None, :].astype(x.dtype), window_strides=(1,),
                                   padding=[(pad, pad)], dimension_numbers=('NWC', 'WIO', 'NWC'),
                                   feature_group_count=x.shape[-1])
    return out + b


def ssm_prep(xbc, dtf, dtb, p):
    B, L, _ = xbc.shape
    xbc = jax.nn.silu(dwconv_centred(xbc, p["ssm_conv_w"], p["ssm_conv_b"]))
    xs, Bm, Cm = _split(xbc, (SSM_INNER, SSM_GROUPS * SSM_STATE, SSM_GROUPS * SSM_STATE))
    xs = xs.reshape(B, L, SSM_HEADS, SSM_HEADDIM)
    Bm = Bm.reshape(B, L, SSM_GROUPS, SSM_STATE)
    Cm = Cm.reshape(B, L, SSM_GROUPS, SSM_STATE)
    dt_bias = p["ssm_dt_bias"].astype(jnp.float32)
    dt_f = jax.nn.softplus(dtf.astype(jnp.float32) + dt_bias[0])
    dt_b = jax.nn.softplus(dtb.astype(jnp.float32) + dt_bias[1])
    return xs, Bm, Cm, dt_f, dt_b


def ssd(x, dt, A, Bm, Cm, h0, need_y):
    Bsz, L, H, P = x.shape
    N = Bm.shape[-1]
    Q = SSM_CHUNK
    nc = L // Q
    rep = H // Bm.shape[2]
    Bc = jnp.repeat(Bm, rep, axis=2).astype(jnp.float32).reshape(Bsz, nc, Q, H, N)
    Cc = jnp.repeat(Cm, rep, axis=2).astype(jnp.float32).reshape(Bsz, nc, Q, H, N)
    xs = x.astype(jnp.float32).reshape(Bsz, nc, Q, H, P)
    dtc = dt.reshape(Bsz, nc, Q, H)
    a_cum = jnp.cumsum(dtc * A, axis=2)
    a_tot = a_cum[:, :, -1]
    w_state = jnp.exp(a_tot[:, :, None] - a_cum) * dtc
    S = jnp.einsum('bcqh,bcqhn,bcqhp->bchpn', w_state, Bc, xs)

    def step(h, inp):
        decay, s = inp
        return decay[:, :, None, None] * h + s, h

    h_last, h_prev = lax.scan(step, h0, (jnp.moveaxis(jnp.exp(a_tot), 1, 0), jnp.moveaxis(S, 1, 0)))
    if not need_y:
        return None, h_last
    h_prev = jnp.moveaxis(h_prev, 0, 1)
    y_inter = jnp.einsum('bcqhn,bchpn->bcqhp', Cc, h_prev) * jnp.exp(a_cum)[..., None]
    mask = jnp.tril(jnp.ones((Q, Q), dtype=bool))
    diff = a_cum[:, :, :, None, :] - a_cum[:, :, None, :, :]
    decay_mat = jnp.exp(jnp.where(mask[None, None, :, :, None], diff, -jnp.inf))
    scores = jnp.einsum('bcihn,bcjhn->bcijh', Cc, Bc) * decay_mat * dtc[:, :, None, :, :]
    y_intra = jnp.einsum('bcijh,bcjhp->bcihp', scores, xs)
    y = (y_intra + y_inter).reshape(Bsz, L, H, P)
    return y.astype(x.dtype), h_last


def ssm_bidir(lat, ctx, p, with_ctx):
    xl, Bl, Cl, dfl, dbl = lat
    xc, Bc, Cc, dfc, dbc = ctx
    A = -jnp.exp(p["ssm_a_log"].astype(jnp.float32))
    Bsz = xl.shape[0]
    h0 = jnp.zeros((Bsz, SSM_HEADS, SSM_HEADDIM, SSM_STATE), jnp.float32)
    fl = lambda t: jnp.flip(t, axis=1)
    yc_f, hc_f = ssd(xc, dfc, A[0], Bc, Cc, h0, with_ctx)
    yl_f, _ = ssd(xl, dfl, A[0], Bl, Cl, hc_f, True)
    yc_b, hc_b = ssd(fl(xc), fl(dbc), A[1], fl(Bc), fl(Cc), h0, with_ctx)
    yl_b, _ = ssd(fl(xl), fl(dbl), A[1], fl(Bl), fl(Cl), hc_b, True)
    d = p["ssm_d"][None, None, :, None]
    y_l = yl_f + fl(yl_b) + d * xl
    y_c = (yc_f + fl(yc_b) + d * xc) if with_ctx else None
    return y_l, y_c


def ssm_out(y, z, p):
    B, L = y.shape[:2]
    y = y.reshape(B, L, SSM_INNER) * jax.nn.silu(z)
    return rmsnorm(y, p["ssm_norm"]) @ p["ssm_w_o"]


def spatial_gating(uv, p):
    B, L, _ = uv.shape
    u, v = jnp.split(jax.nn.gelu(uv), 2, axis=-1)
    v = layernorm(v, p["gm_norm"])
    nc = L // GM_CHUNK
    vg = v.reshape(B, nc, GM_CHUNK, GM_GROUPS, GM_GDIM)
    mixed = jnp.einsum('gij,bcjgd->bcigd', p["gm_w_s"], vg) + p["gm_b_s"].T[:, :, None]
    return (u * mixed.reshape(B, L, GM_WIDTH)) @ p["gm_w_o"]


def merge(o_mla, o_ssm, o_gm, gate_raw, p):
    g_a, g_b, g_c = jnp.split(jax.nn.sigmoid(gate_raw + p["b_gate"]), N_BRANCH, axis=-1)
    return (g_a * o_mla + g_b * o_ssm + g_c * o_gm) @ p["w_out"]


def token_mixer(h_lat, h_ctx, cos, sin, p, with_ctx):
    B, L, _ = h_lat.shape
    w_in = p["w_in"]
    proj_lat = h_lat @ w_in
    proj_ctx = h_ctx @ (w_in if with_ctx else w_in[:, :KV_SIDE])
    kv_l, kr_l, xbc_l, dtf_l, dtb_l = _split(proj_lat[..., :KV_SIDE], KV_SIZES)
    kv_c, kr_c, xbc_c, dtf_c, dtb_c = _split(proj_ctx[..., :KV_SIDE], KV_SIZES)
    q_l, z_l, uv_l, gr_l = _split(proj_lat[..., KV_SIDE:], Q_SIZES)

    kn_l, v_l = mla_keys(kv_l, p)
    kn_c, v_c = mla_keys(kv_c, p)
    kr_l = apply_rope(kr_l, cos, sin)
    qn_l, qr_l = mla_queries(q_l, p)
    qr_l = apply_rope(qr_l, cos[:, None, :], sin[:, None, :])
    a_l = block_attention(qn_l, qr_l, jnp.concatenate([kn_l, kn_c], axis=1),
                          jnp.concatenate([kr_l, kr_c], axis=1), jnp.concatenate([v_l, v_c], axis=1))
    o_mla_l = a_l @ p["mla_w_o"]

    y_ssm_l, y_ssm_c = ssm_bidir(ssm_prep(xbc_l, dtf_l, dtb_l, p), ssm_prep(xbc_c, dtf_c, dtb_c, p), p, with_ctx)
    o_ssm_l = ssm_out(y_ssm_l, z_l, p)

    o_gm_l = spatial_gating(uv_l, p)
    y_lat = merge(o_mla_l, o_ssm_l, o_gm_l, gr_l, p)

    if not with_ctx:
        return y_lat, None
    q_c, z_c, uv_c, gr_c = _split(proj_ctx[..., KV_SIDE:], Q_SIZES)
    qn_c, qr_c = mla_queries(q_c, p)
    o_mla_c = block_attention(qn_c, qr_c, kn_c, kr_c, v_c) @ p["mla_w_o"]
    o_ssm_c = ssm_out(y_ssm_c, z_c, p)
    o_gm_c = spatial_gating(uv_c, p)
    y_ctx = merge(o_mla_c, o_ssm_c, o_gm_c, gr_c, p)
    return y_lat, y_ctx


def setup_inputs(seed: int = 0) -> dict:
    key = jax.random.key(seed)
    ks = iter(jax.random.split(key, 48))
    f32 = jnp.float32
    L = DEPTH
    D = D_MODEL

    def dense(shape, fan_in, gain=1.0):
        return jax.random.normal(next(ks), shape, f32) * (gain * fan_in ** -0.5)

    def gains(shape):
        return 1.0 + 0.05 * jax.random.normal(next(ks), shape, f32)

    def small(shape):
        return 0.01 * jax.random.normal(next(ks), shape, f32)

    dt0 = jnp.exp(jax.random.uniform(next(ks), (L, 2, SSM_HEADS), f32, math.log(1e-3), math.log(1e-1)))
    a0 = jax.random.uniform(next(ks), (L, 2, SSM_HEADS), f32, 1.0, 16.0)
    return {
        "x": jax.random.normal(next(ks), (BATCH, SEQ, D), f32),
        "c": jax.random.normal(next(ks), (BATCH, D), f32),
        "ctx": jax.random.normal(next(ks), (BATCH, CTX_LEN, D), f32),
        "c_ctx": jax.random.normal(next(ks), (D,), f32),
        "w_ada": dense((L, D, N_MOD * D), D, 0.5),
        "b_ada": small((L, N_MOD * D)),
        "norm_g": gains((L, 3, D)),
        "ffn1_w_in": dense((L, D, 2 * D_FF), D),
        "ffn1_w_out": dense((L, D_FF, D), D_FF),
        "ffn2_w_in": dense((L, D, 2 * D_FF), D),
        "ffn2_w_out": dense((L, D_FF, D), D_FF),
        "w_in": dense((L, D, D_IN), D),
        "mla_q_norm": gains((L, MLA_Q_RANK)),
        "mla_w_uq": dense((L, MLA_Q_RANK, MLA_HEADS * (MLA_NOPE + MLA_ROPE)), MLA_Q_RANK),
        "mla_kv_norm": gains((L, MLA_KV_RANK)),
        "mla_w_ukv": dense((L, MLA_KV_RANK, MLA_HEADS * (MLA_NOPE + MLA_V)), MLA_KV_RANK),
        "mla_w_o": dense((L, MLA_HEADS * MLA_V, D), MLA_HEADS * MLA_V),
        "ssm_conv_w": dense((L, XBC_DIM, SSM_CONV), SSM_CONV),
        "ssm_conv_b": small((L, XBC_DIM)),
        "ssm_a_log": jnp.log(a0),
        "ssm_dt_bias": dt0 + jnp.log(-jnp.expm1(-dt0)),
        "ssm_d": gains((L, SSM_HEADS)),
        "ssm_norm": gains((L, SSM_INNER)),
        "ssm_w_o": dense((L, SSM_INNER, D), SSM_INNER),
        "gm_norm": gains((L, GM_WIDTH)),
        "gm_w_s": dense((L, GM_GROUPS, GM_CHUNK, GM_CHUNK), GM_CHUNK),
        "gm_b_s": gains((L, GM_GROUPS, GM_CHUNK)),
        "gm_w_o": dense((L, GM_WIDTH, D), GM_WIDTH),
        "b_gate": small((L, N_BRANCH * D)),
        "w_out": dense((L, D, D), D),
        "final_norm": gains((D,)),
    }


def reference(x, c, ctx, c_ctx, w_ada, b_ada, norm_g, ffn1_w_in, ffn1_w_out, ffn2_w_in, ffn2_w_out,
              w_in, mla_q_norm, mla_w_uq, mla_kv_norm, mla_w_ukv, mla_w_o,
              ssm_conv_w, ssm_conv_b, ssm_a_log, ssm_dt_bias, ssm_d, ssm_norm, ssm_w_o,
              gm_norm, gm_w_s, gm_b_s, gm_w_o, b_gate, w_out, final_norm):
    rows = x.shape[1] // GRID_W
    cos, sin = axial_rope_tables(rows)
    for l in range(DEPTH):
        last = l == DEPTH - 1
        p = {
            "w_in": w_in[l], "mla_q_norm": mla_q_norm[l], "mla_w_uq": mla_w_uq[l],
            "mla_kv_norm": mla_kv_norm[l], "mla_w_ukv": mla_w_ukv[l], "mla_w_o": mla_w_o[l],
            "ssm_conv_w": ssm_conv_w[l], "ssm_conv_b": ssm_conv_b[l], "ssm_a_log": ssm_a_log[l],
            "ssm_dt_bias": ssm_dt_bias[l], "ssm_d": ssm_d[l], "ssm_norm": ssm_norm[l], "ssm_w_o": ssm_w_o[l],
            "gm_norm": gm_norm[l], "gm_w_s": gm_w_s[l], "gm_b_s": gm_b_s[l], "gm_w_o": gm_w_o[l],
            "b_gate": b_gate[l], "w_out": w_out[l],
        }
        mx = jnp.split((jax.nn.silu(c) @ w_ada[l] + b_ada[l])[:, None, :], N_MOD, axis=-1)
        mc = jnp.split(jax.nn.silu(c_ctx) @ w_ada[l] + b_ada[l], N_MOD, axis=-1)

        x = x + 0.5 * mx[2] * swiglu(pre(x, norm_g[l, 0], mx[0], mx[1]), ffn1_w_in[l], ffn1_w_out[l])
        ctx = ctx + 0.5 * mc[2] * swiglu(pre(ctx, norm_g[l, 0], mc[0], mc[1]), ffn1_w_in[l], ffn1_w_out[l])

        y_x, y_c = token_mixer(pre(x, norm_g[l, 1], mx[3], mx[4]), pre(ctx, norm_g[l, 1], mc[3], mc[4]),
                               cos, sin, p, not last)
        x = x + mx[5] * y_x

        x = x + 0.5 * mx[8] * swiglu(pre(x, norm_g[l, 2], mx[6], mx[7]), ffn2_w_in[l], ffn2_w_out[l])
        if not last:
            ctx = ctx + mc[5] * y_c
            ctx = ctx + 0.5 * mc[8] * swiglu(pre(ctx, norm_g[l, 2], mc[6], mc[7]), ffn2_w_in[l], ffn2_w_out[l])
    return rmsnorm(x, final_norm)
```

```cpp
#include <hip/hip_runtime.h>
#include <hip/hip_bf16.h>
#include <cstdio>
#include <cstdint>

#ifndef MK_PER_PHASE
#define MK_PER_PHASE 0
#endif

#define LAS __attribute__((address_space(3)))
typedef unsigned short bf16;
typedef short bf16x8 __attribute__((ext_vector_type(8)));
typedef float f32x4 __attribute__((ext_vector_type(4)));
typedef float f32x2 __attribute__((ext_vector_type(2)));
typedef float f32x16 __attribute__((ext_vector_type(16)));
typedef unsigned u32x4 __attribute__((ext_vector_type(4)));
typedef unsigned u32x2 __attribute__((ext_vector_type(2)));
typedef __bf16 bf16x2_t __attribute__((ext_vector_type(2)));

constexpr int DM = 1024, NB = 8, SEQ = 2048, CTXL = 256, NLAT = NB * SEQ, NCTX = NB * CTXL, NTOK = NLAT + NCTX;
constexpr int DFF = 2816, NMOD = 9, MODW = NMOD * DM, DIN = 6064;
constexpr float EPS = 1e-6f;
constexpr float QSCALE = 0.10206207261596577f * 1.4426950408889634f;
constexpr int NWAVES = 8, NTHR = 512;

__device__ __forceinline__ unsigned pk2(float lo, float hi) { f32x2 v = {lo, hi}; bf16x2_t b = __builtin_convertvector(v, bf16x2_t); return __builtin_bit_cast(unsigned, b); }
__device__ __forceinline__ bf16 f2bf(float f) { return (bf16)(pk2(f, 0.f) & 0xffffu); }
__device__ __forceinline__ float bf2f(bf16 b) { return __uint_as_float((unsigned)b << 16); }
__device__ __forceinline__ float bflo(unsigned w) { return __uint_as_float(w << 16); }
__device__ __forceinline__ float bfhi(unsigned w) { return __uint_as_float(w & 0xffff0000u); }
__device__ __forceinline__ u32x4 pack8(f32x4 a, f32x4 b) { u32x4 w; w.x = pk2(a[0], a[1]); w.y = pk2(a[2], a[3]); w.z = pk2(b[0], b[1]); w.w = pk2(b[2], b[3]); return w; }
__device__ __forceinline__ void unpack8(u32x4 w, float* f) { f[0] = bflo(w.x); f[1] = bfhi(w.x); f[2] = bflo(w.y); f[3] = bfhi(w.y); f[4] = bflo(w.z); f[5] = bfhi(w.z); f[6] = bflo(w.w); f[7] = bfhi(w.w); }
__device__ __forceinline__ float rcpf_(float x) { return __builtin_amdgcn_rcpf(x); }
__device__ __forceinline__ float rsqf_(float x) { return __builtin_amdgcn_rsqf(x); }
__device__ __forceinline__ float sigmoidf_(float x) { return rcpf_(1.0f + __expf(-x)); }
__device__ __forceinline__ float siluf_(float x) { return x * rcpf_(1.0f + __expf(-x)); }
__device__ __forceinline__ float gelu_tanh(float x) { const float y = 1.5957691216057308f * (x + 0.044715f * x * x * x); return x * rcpf_(1.0f + __expf(-y)); }
__device__ __forceinline__ float softplusf_(float x) {
    const float e = __expf(-fabsf(x)); const float l = e < 0.01f ? e * (1.0f - e * (0.5f - e * (1.0f / 3.0f))) : __logf(1.0f + e); return fmaxf(x, 0.f) + l; }
__device__ __forceinline__ float wave_sum(float v) {
#pragma unroll
    for (int o = 1; o < 64; o <<= 1) v += __shfl_xor(v, o);
    return v;
}
__device__ __forceinline__ int mod_row(int row) { return row < NLAT ? (row >> 11) : 8; }

namespace pg8 {
#define PG8_LAS __attribute__((address_space(3)))
typedef unsigned short bf16_t;
constexpr int BM = 256, BK = 64, HALF = 128, HTB = HALF * BK * 2, STAGE_BYTES = 8 * HTB, NXCD = 8, WGM = 8;
__host__ __device__ __forceinline__ int lds_byte(int r, int c) { const int st = (r >> 4) * 2 + (c >> 5), rr = r & 15, cc = c & 31, ob = rr * 64 + cc * 2; return st * 1024 + (ob ^ (((ob >> 9) & 1) << 5)); }
__host__ __device__ __forceinline__ void stage_rc(int b, int& R, int& C) { const int st = b / 1024, sb = b % 1024, swz = sb ^ (((sb >> 9) & 1) << 5); R = (st >> 1) * 16 + swz / 64; C = (st & 1) * 32 + (swz % 64) / 2; }
__host__ __device__ __forceinline__ int perm32(int rho) { const int n = rho >> 4, i = rho & 15; return 8 * (i >> 2) + 4 * n + (i & 3); }

struct Unit { int pm, pn; };
struct Gemm { const bf16_t* A; const bf16_t* Bt; int M, N, K, lda, ldb; };

struct StaticOrder {
    int nM, nN, nwg, G, c;
    __host__ __device__ void init(int M, int N, int G_, int c_) { nM = M / BM; nN = N / BM; nwg = nM * nN; G = G_; c = c_; }
    __host__ __device__ bool next(int i, Unit& u) const {
        const long L = (long)i * G + c; if (L >= nwg) return false;
        int wgid = (int)L; { const int q = nwg / NXCD, r = nwg % NXCD, xcd = wgid % NXCD, off = wgid / NXCD; wgid = (xcd < r ? xcd * (q + 1) : r * (q + 1) + (xcd - r) * q) + off; }
        const int nig = WGM * nN, gid = wgid / nig, fm = gid * WGM, gsz = (nM - fm) < WGM ? (nM - fm) : WGM;
        u.pm = fm + ((wgid % nig) % gsz); u.pn = (wgid % nig) / gsz; return true;
    }
    __device__ __forceinline__ void a_ready(const Unit&) const {}
    __device__ __forceinline__ void done(const Unit&) const {}
};

template <class F> struct Epi8 {
    static constexpr bool PERM = true, AFTER_DRAIN = false; F f;
    __device__ __forceinline__ void operator()(const f32x4 (&acc)[2][2][4][2], const Unit& u, int wr, int wc, int fr, int fq) const {
        asm volatile("" : "+v"(fr), "+v"(fq));
#pragma unroll
        for (int ai = 0; ai < 2; ++ai)
#pragma unroll
            for (int m = 0; m < 4; ++m) { const int row = u.pm * BM + ai * HALF + wr * 64 + m * 16 + fr;
#pragma unroll
                for (int bj = 0; bj < 2; ++bj) f(row, u.pn * BM + bj * HALF + wc * 32 + 8 * fq, acc[ai][bj][m][0], acc[ai][bj][m][1]); }
    }
};
template <class F> struct Epi4 {
    static constexpr bool PERM = false, AFTER_DRAIN = false; F f;
    __device__ __forceinline__ void operator()(const f32x4 (&acc)[2][2][4][2], const Unit& u, int wr, int wc, int fr, int fq) const {
        asm volatile("" : "+v"(fr), "+v"(fq));
#pragma unroll
        for (int ai = 0; ai < 2; ++ai)
#pragma unroll
            for (int m = 0; m < 4; ++m) { const int row = u.pm * BM + ai * HALF + wr * 64 + m * 16 + fr;
#pragma unroll
                for (int bj = 0; bj < 2; ++bj)
#pragma unroll
                    for (int n = 0; n < 2; ++n) f(row, u.pn * BM + bj * HALF + wc * 32 + n * 16 + 4 * fq, acc[ai][bj][m][n]); }
    }
};
template <class F> struct EpiGU {
    static constexpr bool PERM = true, AFTER_DRAIN = false; F f;
    __device__ __forceinline__ void operator()(const f32x4 (&acc)[2][2][4][2], const Unit& u, int wr, int wc, int fr, int fq) const {
        asm volatile("" : "+v"(fr), "+v"(fq));
#pragma unroll
        for (int ai = 0; ai < 2; ++ai)
#pragma unroll
            for (int m = 0; m < 4; ++m) { const int row = u.pm * BM + ai * HALF + wr * 64 + m * 16 + fr;
                f(row, u.pn * HALF + wc * 32 + 8 * fq, acc[ai][0][m][0], acc[ai][0][m][1], acc[ai][1][m][0], acc[ai][1][m][1]); }
    }
};

template <class Epi, class Sched, bool ALIGN_EPI = false, bool SP2 = false>
__device__ __forceinline__ void gemm_phase(PG8_LAS unsigned char* lds, const Gemm g, const Sched& S, const Epi& E) {
    int tid = threadIdx.x; asm volatile("" : "+v"(tid));
    const int wid = __builtin_amdgcn_readfirstlane(tid >> 6), lane = tid & 63, wr = wid >> 2, wc = wid & 3, fr = lane & 15, fq = lane >> 4;
    const int K = g.K, nt = K / BK;
    unsigned voffA[2], voffB[2];
#pragma unroll
    for (int i = 0; i < 2; ++i) { int R, C; stage_rc(tid * 16 + i * 8192, R, C); const int Rb = Epi::PERM ? ((R & ~31) + perm32(R & 31)) : R;
        voffA[i] = (unsigned)(R * g.lda + C) * 2u; voffB[i] = (unsigned)(Rb * g.ldb + C) * 2u; }
    const size_t kstep = (size_t)(BK * 2);
    const size_t hstepA = (size_t)HALF * g.lda * 2, hstepB = (size_t)HALF * g.ldb * 2;
    const size_t tstepA = 2 * hstepA, tstepB = 2 * hstepB;
    const unsigned ldsw = (unsigned)wid * 1024u;
    const int aoff = lds_byte(wr * 64 + fr, fq * 8), boff = lds_byte(wc * 32 + fr, fq * 8);
#define PG8_SA(b, h) (((b) * 2 + (h)) * HTB)
#define PG8_SB(b, h) ((4 + (b) * 2 + (h)) * HTB)
#define PG8_STAGE(bufoff, gbase, voff) do { _Pragma("unroll") for (int _i = 0; _i < 2; ++_i) \
        __builtin_amdgcn_global_load_lds((const unsigned*)((const char*)(gbase) + (voff)[_i]), (PG8_LAS unsigned*)(lds + (bufoff) + ldsw + _i * 8192), 16, 0, 0); } while (0)
#define PG8_LDA(dst, b, h) do { _Pragma("unroll") for (int m = 0; m < 4; ++m) _Pragma("unroll") for (int k = 0; k < 2; ++k) dst[m][k] = *(const PG8_LAS bf16x8*)(lds + PG8_SA(b, h) + aoff + m * 2048 + k * 1024); } while (0)
#define PG8_LDB(dst, b, h) do { _Pragma("unroll") for (int n = 0; n < 2; ++n) _Pragma("unroll") for (int k = 0; k < 2; ++k) dst[n][k] = *(const PG8_LAS bf16x8*)(lds + PG8_SB(b, h) + boff + n * 2048 + k * 1024); } while (0)
#define PG8_MMA(ai, bj, At, Bt) do { __builtin_amdgcn_s_setprio(1); _Pragma("unroll") for (int m = 0; m < 4; ++m) _Pragma("unroll") for (int n = 0; n < 2; ++n) _Pragma("unroll") for (int k = 0; k < 2; ++k) \
        acc[ai][bj][m][n] = __builtin_amdgcn_mfma_f32_16x16x32_bf16(Bt[n][k], At[m][k], acc[ai][bj][m][n], 0, 0, 0); __builtin_amdgcn_s_setprio(0); } while (0)
#define PG8_WAIT_V(n) asm volatile("s_waitcnt vmcnt(" #n ")" ::: "memory")
#define PG8_WAIT_L(n) asm volatile("s_waitcnt lgkmcnt(" #n ")" ::: "memory")
#define PG8_BAR __builtin_amdgcn_s_barrier()
#define PG8_SCHED __builtin_amdgcn_sched_barrier(0)
    Unit cur, nxt; int ui = 0;
    if (!S.next(0, cur)) return;
    f32x4 acc[2][2][4][2];
#pragma unroll
    for (int a = 0; a < 2; ++a)
#pragma unroll
        for (int b = 0; b < 2; ++b)
#pragma unroll
            for (int m = 0; m < 4; ++m)
#pragma unroll
                for (int n = 0; n < 2; ++n) acc[a][b][m][n] = (f32x4){0.f, 0.f, 0.f, 0.f};
    bf16x8 At[4][2], B0[2][2], B1[2][2];
    const char* cA = (const char*)g.A + (size_t)cur.pm * tstepA; const char* cB = (const char*)g.Bt + (size_t)cur.pn * tstepB;
    S.a_ready(cur);
    if constexpr (SP2) {
        PG8_STAGE(PG8_SB(0, 0), cB, voffB); PG8_STAGE(PG8_SB(0, 1), cB + hstepB, voffB); PG8_STAGE(PG8_SA(0, 0), cA, voffA); PG8_STAGE(PG8_SA(0, 1), cA + hstepA, voffA);
        if (wr == 1) PG8_BAR;
        PG8_WAIT_V(2); PG8_BAR;
        PG8_STAGE(PG8_SB(1, 0), cB + kstep, voffB); PG8_STAGE(PG8_SA(1, 0), cA + kstep, voffA); PG8_STAGE(PG8_SB(1, 1), cB + hstepB + kstep, voffB);
        PG8_WAIT_V(6); PG8_BAR;
    } else {
        PG8_STAGE(PG8_SB(0, 0), cB, voffB); PG8_STAGE(PG8_SA(0, 0), cA, voffA); PG8_STAGE(PG8_SB(0, 1), cB + hstepB, voffB); PG8_STAGE(PG8_SA(0, 1), cA + hstepA, voffA);
        if (wr == 1) PG8_BAR;
        PG8_WAIT_V(4); PG8_BAR;
        PG8_STAGE(PG8_SB(1, 0), cB + kstep, voffB); PG8_STAGE(PG8_SA(1, 0), cA + kstep, voffA); PG8_STAGE(PG8_SB(1, 1), cB + hstepB + kstep, voffB);
        PG8_WAIT_V(6); PG8_BAR;
    }
    for (;;) {
        const bool has_next = S.next(ui + 1, nxt);
        const char* nA = has_next ? (const char*)g.A + (size_t)nxt.pm * tstepA : cA; const char* nB = has_next ? (const char*)g.Bt + (size_t)nxt.pn * tstepB : cB;
#pragma clang loop unroll(disable)
        for (int t = 0; t < nt; t += 2) {
            const bool last = (t == nt - 2);
            const char* a1 = cA + (size_t)(t + 1) * kstep;
            const char* a2 = last ? nA : cA + (size_t)(t + 2) * kstep; const char* b2 = last ? nB : cB + (size_t)(t + 2) * kstep;
            const char* a3 = a2 + kstep; const char* b3 = b2 + kstep;
            if (last && has_next) S.a_ready(nxt);
            if constexpr (SP2) {
            PG8_LDB(B0, 0, 0); PG8_LDB(B1, 0, 1); PG8_SCHED; PG8_LDA(At, 0, 0); PG8_STAGE(PG8_SA(1, 1), a1 + hstepA, voffA);
            PG8_WAIT_V(8); PG8_WAIT_L(0); PG8_BAR; PG8_MMA(0, 0, At, B0); PG8_MMA(0, 1, At, B1); PG8_BAR; PG8_SCHED;
            PG8_LDA(At, 0, 1); PG8_STAGE(PG8_SB(0, 0), b2, voffB); PG8_STAGE(PG8_SB(0, 1), b2 + hstepB, voffB); PG8_STAGE(PG8_SA(0, 0), a2, voffA);
            PG8_WAIT_V(8); PG8_WAIT_L(0); PG8_BAR; PG8_MMA(1, 0, At, B0); PG8_MMA(1, 1, At, B1); PG8_BAR; PG8_SCHED;
            PG8_LDB(B0, 1, 0); PG8_LDB(B1, 1, 1); PG8_SCHED; PG8_LDA(At, 1, 0); PG8_STAGE(PG8_SA(0, 1), a2 + hstepA, voffA);
            PG8_WAIT_V(8); PG8_WAIT_L(0); PG8_BAR; PG8_MMA(0, 0, At, B0); PG8_MMA(0, 1, At, B1); PG8_BAR; PG8_SCHED;
            PG8_LDA(At, 1, 1); PG8_STAGE(PG8_SB(1, 0), b3, voffB); PG8_STAGE(PG8_SB(1, 1), b3 + hstepB, voffB); PG8_STAGE(PG8_SA(1, 0), a3, voffA);
            PG8_WAIT_V(8); PG8_WAIT_L(0); PG8_BAR; PG8_MMA(1, 0, At, B0); PG8_MMA(1, 1, At, B1); PG8_BAR; PG8_SCHED;
            } else {
            PG8_LDB(B0, 0, 0); PG8_SCHED; PG8_LDA(At, 0, 0); PG8_STAGE(PG8_SA(1, 1), a1 + hstepA, voffA);
            PG8_WAIT_L(8); PG8_BAR; PG8_WAIT_L(0); PG8_MMA(0, 0, At, B0); PG8_BAR; PG8_SCHED;
            PG8_LDB(B1, 0, 1); PG8_STAGE(PG8_SB(0, 0), b2, voffB);
            PG8_BAR; PG8_WAIT_L(0); PG8_MMA(0, 1, At, B1); PG8_BAR;
            PG8_LDA(At, 0, 1); PG8_STAGE(PG8_SA(0, 0), a2, voffA);
            PG8_BAR; PG8_WAIT_L(0); PG8_MMA(1, 0, At, B0); PG8_BAR; PG8_SCHED;
            PG8_STAGE(PG8_SB(0, 1), b2 + hstepB, voffB);
            PG8_WAIT_V(6); PG8_BAR; PG8_MMA(1, 1, At, B1); PG8_BAR;
            PG8_LDB(B0, 1, 0); PG8_SCHED; PG8_LDA(At, 1, 0); PG8_STAGE(PG8_SA(0, 1), a2 + hstepA, voffA);
            PG8_WAIT_L(8); PG8_BAR; PG8_WAIT_L(0); PG8_MMA(0, 0, At, B0); PG8_BAR; PG8_SCHED;
            PG8_LDB(B1, 1, 1); PG8_STAGE(PG8_SB(1, 0), b3, voffB);
            PG8_BAR; PG8_WAIT_L(0); PG8_MMA(0, 1, At, B1); PG8_BAR;
            PG8_LDA(At, 1, 1); PG8_STAGE(PG8_SA(1, 0), a3, voffA);
            PG8_BAR; PG8_WAIT_L(0); PG8_MMA(1, 0, At, B0); PG8_BAR; PG8_SCHED;
            PG8_STAGE(PG8_SB(1, 1), b3 + hstepB, voffB);
            PG8_WAIT_V(6); PG8_BAR; PG8_MMA(1, 1, At, B1); PG8_BAR;
            }
        }
        if constexpr (ALIGN_EPI) { if (wr == 0) PG8_BAR; }
        if constexpr (!Epi::AFTER_DRAIN) { E(acc, cur, wr, wc, fr, fq); S.done(cur); }
        if (!has_next) break;
#pragma unroll
        for (int a = 0; a < 2; ++a)
#pragma unroll
            for (int b = 0; b < 2; ++b)
#pragma unroll
                for (int m = 0; m < 4; ++m)
#pragma unroll
                    for (int n = 0; n < 2; ++n) acc[a][b][m][n] = (f32x4){0.f, 0.f, 0.f, 0.f};
        cur = nxt; cA = nA; cB = nB; ++ui;
        if constexpr (ALIGN_EPI) { if (wr == 1) PG8_BAR; }
    }
    PG8_WAIT_V(0);
    if constexpr (!ALIGN_EPI) { if (wr == 0) PG8_BAR; }
    PG8_BAR;
#undef PG8_SA
#undef PG8_SB
#undef PG8_STAGE
#undef PG8_LDA
#undef PG8_LDB
#undef PG8_MMA
#undef PG8_WAIT_V
#undef PG8_WAIT_L
#undef PG8_BAR
#undef PG8_SCHED
}
}

constexpr size_t MiB = 1u << 20;
constexpr size_t WS_CTL = 0, CTL_ZERO_BYTES = 1 * MiB;
constexpr size_t WS_MOD = 1 * MiB;
constexpr size_t WS_ROPE = 2 * MiB;
constexpr size_t WS_STAT = 3 * MiB;
constexpr size_t WS_W = 4 * MiB;
constexpr size_t WS_XCTX = 56 * MiB;
constexpr size_t WS_H = 64 * MiB;
constexpr size_t WS_BIG = 100 * MiB;
constexpr size_t B_KVR = WS_BIG + 0 * MiB, B_QLAT = WS_BIG + 9 * MiB, B_AMLA = WS_BIG + 0 * MiB;
constexpr size_t B_XBCR = WS_BIG + 18 * MiB, B_YF = WS_BIG + 18 * MiB, B_YB = WS_BIG + 36 * MiB;
constexpr size_t B_UV = WS_BIG + 54 * MiB, B_SZ = WS_BIG + 90 * MiB;
constexpr size_t B_Q = WS_BIG + 108 * MiB, B_KN = WS_BIG + 135 * MiB, B_KRP = WS_BIG + 153 * MiB, B_V = WS_BIG + 155 * MiB, B_XBC = WS_BIG + 173 * MiB, B_DT = WS_BIG + 209 * MiB;
constexpr size_t B_GATES = WS_BIG + 108 * MiB, B_ACT = WS_BIG + 0 * MiB;
constexpr size_t WS_END = WS_BIG + 216 * MiB;
constexpr size_t W_F1I = 0, W_F1O = W_F1I + (size_t)5632 * 1024, W_F2I = W_F1O + (size_t)1024 * 2816, W_F2O = W_F2I + (size_t)5632 * 1024;
constexpr size_t W_INA = W_F2O + (size_t)1024 * 2816, W_GATE = W_INA + (size_t)3072 * 1024, W_UQ = W_GATE + (size_t)3072 * 1024, W_UKV = W_UQ + (size_t)768 * 256;
constexpr size_t W_MO = W_UKV + (size_t)1024 * 256, W_SO = W_MO + (size_t)1024 * 512, W_GO = W_SO + (size_t)1024 * 512, W_OUT = W_GO + (size_t)1024 * 512, W_GS = W_OUT + (size_t)1024 * 1024, W_ENDW = W_GS + (size_t)8 * 128 * 128;
static_assert(W_ENDW * 2 <= 52 * MiB, "weights fit");
constexpr int CW_BAR = 4096;
constexpr int CW_QUEUE = 16384;

constexpr int LDS_PHASE_BYTES = 147456;
constexpr int MISC_OFF = LDS_PHASE_BYTES;
constexpr int LDS_BYTES = LDS_PHASE_BYTES + 256;

#define XB_TMO      128
#define XB_XCNT(j)  (256  + 64 * (j))
#define XB_XSUB(j)  (1280 + 64 * (j))
#define XB_XGEN(j)  (2304 + 64 * (j))
#define XB_TOP      3328
#define XB_TOPGEN   3392
#define XCD_BAR_WORDS 3456
#define XB_SPIN_CAP (1u << 22)
__device__ __forceinline__ unsigned xb_ld(unsigned* p)              { return __hip_atomic_load(p, __ATOMIC_RELAXED, __HIP_MEMORY_SCOPE_AGENT); }
__device__ __forceinline__ unsigned xb_add(unsigned* p, unsigned v) { return __hip_atomic_fetch_add(p, v, __ATOMIC_RELAXED, __HIP_MEMORY_SCOPE_AGENT); }
__device__ __forceinline__ unsigned xb_xcc_id() { return (unsigned)__builtin_amdgcn_s_getreg((3 << 11) | 20) & 0xFu; }
#define XB_SPIN(cond, bar) do { unsigned _sp = 0; while (cond) { __builtin_amdgcn_s_sleep(1); \
    if ((++_sp & 255u) == 0u) { if (xb_ld(&(bar)[XB_TMO])) break; if (_sp > XB_SPIN_CAP) { atomicAdd(&(bar)[XB_TMO], 1u); break; } } } } while (0)
struct XcdBarrier { unsigned* bar; unsigned x; volatile LAS unsigned* st; };
__device__ __forceinline__ XcdBarrier xcd_barrier_post(unsigned* bar, volatile LAS unsigned* st) {
    XcdBarrier b; b.bar = bar; b.x = xb_xcc_id(); b.st = st;
    if (threadIdx.x == 0) (void)xb_add(&bar[XB_XCNT(b.x)], 1u);
    return b;
}
__device__ __forceinline__ void xcd_barrier_complete(unsigned* bar, unsigned x, unsigned& nloc, unsigned& nx) {
    const unsigned G = gridDim.x * gridDim.y * gridDim.z;
    unsigned sum, cnt, mine, sp = 0u;
    for (;;) {
        sum = 0u; cnt = 0u; mine = 0u;
#pragma unroll
        for (unsigned j = 0; j < 16; ++j) { const unsigned c = xb_ld(&bar[XB_XCNT(j)]); sum += c; cnt += (c > 0u) ? 1u : 0u; mine = (j == x) ? c : mine; }
        if (sum == G) break;
        __builtin_amdgcn_s_sleep(1);
        if ((++sp & 255u) == 0u) { if (xb_ld(&bar[XB_TMO])) break; if (sp > XB_SPIN_CAP) { atomicAdd(&bar[XB_TMO], 1u); break; } }
    }
    nloc = mine > 0u ? mine : 1u; nx = cnt > 0u ? cnt : 1u;
}
__device__ __forceinline__ void xcd_barrier(const XcdBarrier& b) {
    asm volatile("s_waitcnt vmcnt(0)" ::: "memory");
    __syncthreads();
    if (threadIdx.x == 0) {
        unsigned* bar = b.bar;
        __builtin_amdgcn_s_waitcnt(0);
        unsigned nloc = b.st[0], nx = b.st[1];
        if (nloc == 0u) { xcd_barrier_complete(bar, b.x, nloc, nx); b.st[0] = nloc; b.st[1] = nx; }
        const unsigned old = xb_add(&bar[XB_XSUB(b.x)], 1u);
        const unsigned gen = old / nloc;
        if (old + 1u == (gen + 1u) * nloc) {
            __builtin_amdgcn_fence(__ATOMIC_RELEASE, "agent");
            asm volatile("s_waitcnt vmcnt(0)" ::: "memory");
            const unsigned og = xb_add(&bar[XB_TOP], 1u);
            const unsigned tg = og / nx;
            if (og + 1u == (tg + 1u) * nx) xb_add(&bar[XB_TOPGEN], 1u);
            else XB_SPIN(xb_ld(&bar[XB_TOPGEN]) == tg, bar);
            __builtin_amdgcn_fence(__ATOMIC_ACQUIRE, "agent");
            xb_add(&bar[XB_XGEN(b.x)], 1u);
            asm volatile("s_waitcnt vmcnt(0)" ::: "memory");
        } else {
            XB_SPIN(xb_ld(&bar[XB_XGEN(b.x)]) == gen, bar);
            __builtin_amdgcn_fence(__ATOMIC_ACQUIRE, "agent");
            asm volatile("s_waitcnt vmcnt(0)" ::: "memory");
        }
    }
    __syncthreads();
}

struct Args { const float* in[31]; float* out; unsigned char* ws; int ph_lo, ph_hi; };
enum { I_X = 0, I_C, I_CTX, I_CCTX, I_WADA, I_BADA, I_NORMG, I_F1WI, I_F1WO, I_F2WI, I_F2WO, I_WIN, I_QNORM, I_WUQ, I_KVNORM, I_WUKV, I_WMO,
       I_CONVW, I_CONVB, I_ALOG, I_DTBIAS, I_SSMD, I_SSMNORM, I_WSO, I_GMNORM, I_GMWS, I_GMBS, I_GMWO, I_BGATE, I_WOUT, I_FNORM };

struct Frame {
    LAS unsigned char* lds;
    int tid, lane, wave, G, vcu, bid;
    size_t z;
    const float* const* in; float* out; unsigned char* ws;
};
#define WSP(T, off) ((T*)(F.ws + F.z + (off)))
#define INP(k) (F.in[k] + F.z)
#define OUTP (F.out + F.z)
#define WGT(off) (WSP(bf16, WS_W) + (off))

__device__ __forceinline__ const float* xrow_in(const Frame& F, int row, bool from_inputs) {
    if (from_inputs) return row < NLAT ? INP(I_X) + (size_t)row * DM : INP(I_CTX) + (size_t)(row - NLAT) * DM;
    return row < NLAT ? OUTP + (size_t)row * DM : WSP(float, WS_XCTX) + (size_t)(row - NLAT) * DM;
}
__device__ __forceinline__ float* xrow_out(const Frame& F, int row) { return row < NLAT ? OUTP + (size_t)row * DM : WSP(float, WS_XCTX) + (size_t)(row - NLAT) * DM; }

template <class Map> __device__ __forceinline__ void transpose_items(const Frame& F, int& base, int gw, int NGW, const float* W, int Ksrc, int Nsrc, bf16* WT, int Kdst, int Ndst, const float* kscale, Map map) {
    LAS float* scr = (LAS float*)(F.lds + F.wave * 8448);
    const int nblk = Ndst / 32, nitems = (Kdst / 64) * nblk;
    int first = (gw - (base % NGW) + NGW) % NGW;
    for (int item = first; item < nitems; item += NGW) {
        const int kb = item / nblk, nb = item % nblk, k0 = 64 * kb, n0 = 32 * nb;
        const int sc = map(n0 + (F.lane & 31));
#pragma unroll 8
        for (int i = 0; i < 32; ++i) { const int kk = 2 * i + (F.lane >> 5), k = k0 + kk; float v = 0.f;
            if (sc >= 0 && k < Ksrc) { v = W[(size_t)k * Nsrc + sc]; if (kscale) v *= kscale[k]; }
            scr[kk * 33 + (F.lane & 31)] = v; }
        asm volatile("s_waitcnt lgkmcnt(0)" ::: "memory");
        const int c = F.lane & 7;
#pragma unroll
        for (int j = 0; j < 4; ++j) { const int n = (F.lane >> 3) + 8 * j; const LAS float* s = scr + (8 * c) * 33 + n;
            u32x4 o; o.x = pk2(s[0 * 33], s[1 * 33]); o.y = pk2(s[2 * 33], s[3 * 33]); o.z = pk2(s[4 * 33], s[5 * 33]); o.w = pk2(s[6 * 33], s[7 * 33]);
            *(u32x4*)(WT + (size_t)(n0 + n) * Kdst + k0 + 8 * c) = o; }
        asm volatile("s_waitcnt lgkmcnt(0)" ::: "memory");
    }
    base += nitems;
}
struct MapId { __device__ __forceinline__ int operator()(int n) const { return n; } };
struct MapOff { int off; __device__ __forceinline__ int operator()(int n) const { return n + off; } };
struct MapFfnIn { __device__ __forceinline__ int operator()(int n) const { const int pn = n >> 8, j = n & 255; return j < 128 ? pn * 128 + j : DFF + pn * 128 + (j - 128); } };
__device__ __forceinline__ int rope_src(int w) { const int blk = w >> 3, half = (w >> 2) & 1, jj = w & 3, i = blk * 4 + jj; return half ? 16 + i : i; }
struct MapInA { __device__ __forceinline__ int operator()(int n) const {
    if (n < 128) return n;
    if (n < 160) return 128 + rope_src(n - 128);
    if (n < 176) return 1184 + (n - 160);
    if (n < 256) return -1;
    if (n < 1280) return 160 + (n - 256);
    if (n < 1536) return 1200 + (n - 1280);
    if (n < 2048) return 1456 + (n - 1536);
    return 1968 + (n - 2048);
} };
struct MapUq { __device__ __forceinline__ int operator()(int n) const {
    if (n < 512) return 96 * (n >> 6) + (n & 63);
    const int c = n - 512, h = c >> 5; return 96 * h + 64 + rope_src(c & 31);
} };

__device__ __forceinline__ void convert_weights(const Frame& F, int l) {
    const int gw = F.vcu * NWAVES + F.wave, NGW = F.G * NWAVES; int base = 0;
    transpose_items(F, base, gw, NGW, INP(I_F1WI) + (size_t)l * DM * 2 * DFF, DM, 2 * DFF, WGT(W_F1I), DM, 2 * DFF, nullptr, MapFfnIn{});
    transpose_items(F, base, gw, NGW, INP(I_F1WO) + (size_t)l * DFF * DM, DFF, DM, WGT(W_F1O), DFF, DM, nullptr, MapId{});
    transpose_items(F, base, gw, NGW, INP(I_F2WI) + (size_t)l * DM * 2 * DFF, DM, 2 * DFF, WGT(W_F2I), DM, 2 * DFF, nullptr, MapFfnIn{});
    transpose_items(F, base, gw, NGW, INP(I_F2WO) + (size_t)l * DFF * DM, DFF, DM, WGT(W_F2O), DFF, DM, nullptr, MapId{});
    transpose_items(F, base, gw, NGW, INP(I_WIN) + (size_t)l * DM * DIN, DM, DIN, WGT(W_INA), DM, 3072, nullptr, MapInA{});
    transpose_items(F, base, gw, NGW, INP(I_WIN) + (size_t)l * DM * DIN, DM, DIN, WGT(W_GATE), DM, 3072, nullptr, MapOff{2992});
    transpose_items(F, base, gw, NGW, INP(I_WUQ) + (size_t)l * 256 * 768, 256, 768, WGT(W_UQ), 256, 768, INP(I_QNORM) + l * 256, MapUq{});
    transpose_items(F, base, gw, NGW, INP(I_WUKV) + (size_t)l * 128 * 1024, 128, 1024, WGT(W_UKV), 256, 1024, INP(I_KVNORM) + l * 128, MapId{});
    transpose_items(F, base, gw, NGW, INP(I_WMO) + (size_t)l * 512 * 1024, 512, 1024, WGT(W_MO), 512, 1024, nullptr, MapId{});
    transpose_items(F, base, gw, NGW, INP(I_WSO) + (size_t)l * 512 * 1024, 512, 1024, WGT(W_SO), 512, 1024, nullptr, MapId{});
    transpose_items(F, base, gw, NGW, INP(I_GMWO) + (size_t)l * 512 * 1024, 512, 1024, WGT(W_GO), 512, 1024, nullptr, MapId{});
    transpose_items(F, base, gw, NGW, INP(I_WOUT) + (size_t)l * 1024 * 1024, 1024, 1024, WGT(W_OUT), 1024, 1024, nullptr, MapId{});
    const float* gs = INP(I_GMWS) + (size_t)l * 131072; bf16* gd = WGT(W_GS);
    for (int i = (F.bid * NTHR + F.tid) * 4; i < 131072; i += F.G * NTHR * 4) { const f32x4 v = *(const f32x4*)(gs + i); u32x2 o; o.x = pk2(v[0], v[1]); o.y = pk2(v[2], v[3]); *(u32x2*)(gd + i) = o; }
}

__device__ __forceinline__ void prologue_mod(const Frame& F) {
    LAS float* sc = (LAS float*)(F.lds + 69632);
    LAS float* red = (LAS float*)(F.lds + 69632 + 36864);
    for (int i = F.tid; i < 9 * 1024; i += NTHR) { const int r = i >> 10, k = i & 1023; const float v = r < 8 ? INP(I_C)[r * 1024 + k] : INP(I_CCTX)[k]; sc[i] = siluf_(v); }
    __syncthreads();
    for (int u = F.bid; u < 2 * 144; u += F.G) {
        const int l = u / 144, j0 = (u % 144) * 64;
        const float* W = INP(I_WADA) + (size_t)l * DM * MODW + j0 + F.lane;
        float a[9];
#pragma unroll
        for (int r = 0; r < 9; ++r) a[r] = 0.f;
        const int kb = F.wave * 128;
#pragma unroll 4
        for (int k = kb; k < kb + 128; ++k) { const float w = W[(size_t)k * MODW];
#pragma unroll
            for (int r = 0; r < 9; ++r) a[r] += sc[r * 1024 + k] * w; }
#pragma unroll
        for (int r = 0; r < 9; ++r) red[(F.wave * 9 + r) * 64 + F.lane] = a[r];
        __syncthreads();
        for (int i = F.tid; i < 9 * 64; i += NTHR) { const int r = i >> 6, c = i & 63; float s = 0.f;
#pragma unroll
            for (int w = 0; w < 8; ++w) s += red[(w * 9 + r) * 64 + c];
            WSP(float, WS_MOD)[(size_t)(l * 9 + r) * MODW + j0 + c] = s + INP(I_BADA)[l * MODW + j0 + c]; }
        __syncthreads();
    }
    float* rope = WSP(float, WS_ROPE);
    for (int i = F.bid * NTHR + F.tid; i < 2048 * 16; i += F.G * NTHR) { const int t = i >> 4, j = i & 15; const float pos = (float)(j < 8 ? (t >> 6) : (t & 63));
        const float inv = powf(10000.0f, -(float)(j & 7) * 0.125f); const float ang = pos * inv; rope[2 * i] = cosf(ang); rope[2 * i + 1] = sinf(ang); }
}

__device__ __forceinline__ void norm_phase(const Frame& F, int l, int which, bool from_inputs, int nrows) {
    const int gw = F.vcu * NWAVES + F.wave, NGW = F.G * NWAVES;
    const float* g = INP(I_NORMG) + (l * 3 + which) * DM; bf16* H = WSP(bf16, WS_H);
    for (int row = gw; row < nrows; row += NGW) {
        const f32x4* xr = (const f32x4*)xrow_in(F, row, from_inputs) + F.lane;
        const float* mod = WSP(float, WS_MOD) + (size_t)(l * 9 + mod_row(row)) * MODW + (3 * which) * DM;
        f32x4 v[4]; float s = 0.f;
#pragma unroll
        for (int j = 0; j < 4; ++j) { v[j] = xr[64 * j]; s += (v[j][0] * v[j][0] + v[j][1] * v[j][1]) + (v[j][2] * v[j][2] + v[j][3] * v[j][3]); }
        const float r = 1.0f / sqrtf(wave_sum(s) * (1.f / DM) + EPS);
        u32x2* o = (u32x2*)(H + (size_t)row * DM) + F.lane;
#pragma unroll
        for (int j = 0; j < 4; ++j) { const int c = 4 * F.lane + 256 * j; const f32x4 gg = *(const f32x4*)(g + c), sh = *(const f32x4*)(mod + c), scl = *(const f32x4*)(mod + DM + c);
            const f32x4 y = v[j] * r * gg * (scl + 1.0f) + sh; u32x2 w; w.x = pk2(y[0], y[1]); w.y = pk2(y[2], y[3]); o[64 * j] = w; }
    }
}
__device__ __forceinline__ void zero_stats(const Frame& F) {
    float* st = WSP(float, WS_STAT);
    for (int i = F.bid * NTHR + F.tid; i < 4 * NTOK; i += F.G * NTHR) st[i] = 0.f;
}
__device__ __forceinline__ void final_norm(const Frame& F) {
    const int gw = F.vcu * NWAVES + F.wave, NGW = F.G * NWAVES; const float* g = INP(I_FNORM);
    for (int row = gw; row < NLAT; row += NGW) {
        f32x4* xr = (f32x4*)(OUTP + (size_t)row * DM) + F.lane;
        f32x4 v[4]; float s = 0.f;
#pragma unroll
        for (int j = 0; j < 4; ++j) { v[j] = xr[64 * j]; s += (v[j][0] * v[j][0] + v[j][1] * v[j][1]) + (v[j][2] * v[j][2] + v[j][3] * v[j][3]); }
        const float r = 1.0f / sqrtf(wave_sum(s) * (1.f / DM) + EPS);
#pragma unroll
        for (int j = 0; j < 4; ++j) { const f32x4 gg = *(const f32x4*)(g + 4 * F.lane + 256 * j); xr[64 * j] = v[j] * r * gg; }
    }
}
__device__ __forceinline__ void conv_phase(const Frame& F, int l, int nrows) {
    const bf16* src = WSP(bf16, B_XBCR); bf16* dst = WSP(bf16, B_XBC);
    const float* cw = INP(I_CONVW) + (size_t)l * 1024 * 5; const float* cb = INP(I_CONVB) + l * 1024;
    const int nitems = (nrows / 16) * 128;
    for (int it = F.bid * NTHR + F.tid; it < nitems; it += F.G * NTHR) {
        const int cg = it & 127, rb = it >> 7, c0 = cg * 8, R = rb * 16;
        int s0, s1; if (R < NLAT) { s0 = R & ~2047; s1 = s0 + 2048; } else { s0 = NLAT + ((R - NLAT) & ~255); s1 = s0 + 256; }
        float w[8][5], b[8];
#pragma unroll
        for (int c = 0; c < 8; ++c) { b[c] = cb[c0 + c];
#pragma unroll
            for (int k = 0; k < 5; ++k) w[c][k] = cw[(c0 + c) * 5 + k]; }
        float win[5][8];
#pragma unroll
        for (int k = 0; k < 4; ++k) { const int r = R - 2 + k; u32x4 v = (u32x4){0u, 0u, 0u, 0u}; if (r >= s0 && r < s1) v = *(const u32x4*)(src + (size_t)r * 1024 + c0); unpack8(v, win[k + 1]); }
#pragma unroll
        for (int o = 0; o < 16; ++o) {
#pragma unroll
            for (int k = 0; k < 4; ++k)
#pragma unroll
                for (int c = 0; c < 8; ++c) win[k][c] = win[k + 1][c];
            { const int r = R + o + 2; u32x4 v = (u32x4){0u, 0u, 0u, 0u}; if (r >= s0 && r < s1) v = *(const u32x4*)(src + (size_t)r * 1024 + c0); unpack8(v, win[4]); }
            float y[8];
#pragma unroll
            for (int c = 0; c < 8; ++c) { float a = b[c];
#pragma unroll
                for (int k = 0; k < 5; ++k) a += w[c][k] * win[k][c];
                y[c] = siluf_(a); }
            u32x4 ov; ov.x = pk2(y[0], y[1]); ov.y = pk2(y[2], y[3]); ov.z = pk2(y[4], y[5]); ov.w = pk2(y[6], y[7]);
            *(u32x4*)(dst + (size_t)(R + o) * 1024 + c0) = ov;
        }
    }
}
__device__ __forceinline__ void ssm_out_prep(const Frame& F, int l, int nrows) {
    const int gw = F.vcu * NWAVES + F.wave, NGW = F.G * NWAVES; const float* g = INP(I_SSMNORM) + l * 512;
    bf16* YF = WSP(bf16, B_YF); const bf16* YB = WSP(bf16, B_YB); const bf16* SZ = WSP(bf16, B_SZ);
    float gg[8];
#pragma unroll
    for (int c = 0; c < 8; ++c) gg[c] = g[F.lane * 8 + c];
    for (int row = gw; row < nrows; row += NGW) {
        const size_t o = (size_t)row * 512 + F.lane * 8;
        float a[8], b[8], z[8]; unpack8(*(const u32x4*)(YF + o), a); unpack8(*(const u32x4*)(YB + o), b); unpack8(*(const u32x4*)(SZ + o), z);
        float s = 0.f;
#pragma unroll
        for (int c = 0; c < 8; ++c) { a[c] = (a[c] + b[c]) * z[c]; s += a[c] * a[c]; }
        const float r = 1.0f / sqrtf(wave_sum(s) * (1.f / 512.f) + EPS);
        u32x4 ov; ov.x = pk2(a[0] * r * gg[0], a[1] * r * gg[1]); ov.y = pk2(a[2] * r * gg[2], a[3] * r * gg[3]); ov.z = pk2(a[4] * r * gg[4], a[5] * r * gg[5]); ov.w = pk2(a[6] * r * gg[6], a[7] * r * gg[7]);
        *(u32x4*)(YF + o) = ov;
    }
}

struct FSwiglu { bf16* ACT;
    __device__ __forceinline__ void operator()(int row, int oc, f32x4 g0, f32x4 g1, f32x4 u0, f32x4 u1) const {
        f32x4 a0, a1;
#pragma unroll
        for (int j = 0; j < 4; ++j) { a0[j] = siluf_(g0[j]) * u0[j]; a1[j] = siluf_(g1[j]) * u1[j]; }
        *(u32x4*)(ACT + (size_t)row * DFF + oc) = pack8(a0, a1);
    } };
struct FResid { const float* in_x; const float* in_ctx; float* out; float* xctx; const float* mod; int gate_idx; float coef; int from_inputs;
    __device__ __forceinline__ void operator()(int row, int col, f32x4 v) const {
        const float* a_ = in_x; const float* b_ = in_ctx; float* o_ = out; float* c_ = xctx; const float* m_ = mod; const int gi = gate_idx, fi = from_inputs; const float cf = coef;
        const bool lat = row < NLAT; const size_t off = (size_t)(lat ? row : row - NLAT) * DM + col;
        const float* s0 = fi ? a_ : o_; const float* s1 = fi ? b_ : c_;
        const float* src = lat ? s0 : s1; float* dst = lat ? o_ : c_;
        const f32x4 gt = *(const f32x4*)(m_ + (size_t)mod_row(row) * MODW + gi * DM + col);
        const f32x4 xo = *(const f32x4*)(src + off);
        *(f32x4*)(dst + off) = xo + gt * v * cf;
    } };
struct FGates { bf16* GATES; const float* bg;
    __device__ __forceinline__ void operator()(int row, int col, f32x4 v0, f32x4 v1) const {
        const f32x4 b0 = *(const f32x4*)(bg + col), b1 = *(const f32x4*)(bg + col + 4); f32x4 a0, a1;
#pragma unroll
        for (int j = 0; j < 4; ++j) { a0[j] = sigmoidf_(v0[j] + b0[j]); a1[j] = sigmoidf_(v1[j] + b1[j]); }
        *(u32x4*)(GATES + (size_t)row * 3072 + col) = pack8(a0, a1);
    } };
struct FMerge { const bf16* GATES; bf16* MERGED; int br;
    __device__ __forceinline__ void operator()(int row, int col, f32x4 v0, f32x4 v1) const {
        float g[8]; unpack8(*(const u32x4*)(GATES + (size_t)row * 3072 + br * 1024 + col), g);
        float o[8];
#pragma unroll
        for (int j = 0; j < 4; ++j) { o[j] = g[j] * v0[j]; o[4 + j] = g[4 + j] * v1[j]; }
        if (br > 0) { float p[8]; unpack8(*(const u32x4*)(MERGED + (size_t)row * DM + col), p);
#pragma unroll
            for (int j = 0; j < 8; ++j) o[j] += p[j]; }
        u32x4 w; w.x = pk2(o[0], o[1]); w.y = pk2(o[2], o[3]); w.z = pk2(o[4], o[5]); w.w = pk2(o[6], o[7]);
        *(u32x4*)(MERGED + (size_t)row * DM + col) = w;
    } };
struct FKvUp { unsigned char* ws;
    __device__ __forceinline__ void operator()(int row, int col, f32x4 v0, f32x4 v1) const {
        unsigned char* w_ = ws; const float* rss = (const float*)(w_ + WS_STAT);
        const float r = rsqf_(rss[row] * (1.f / 128.f) + EPS);
        const int h = col >> 7, e = col & 127; const size_t boff = (e < 64 ? B_KN : B_V - 128) ;
        bf16* dst = (bf16*)(w_ + boff) + (size_t)row * 512 + h * 64 + e;
        *(u32x4*)dst = pack8(v0 * r, v1 * r);
    } };
struct FQUp { unsigned char* ws;
    __device__ __forceinline__ void operator()(int row, int col, f32x4 v0, f32x4 v1) const {
        unsigned char* w_ = ws; const float* rss = (const float*)(w_ + WS_STAT) + NTOK; const float* rope = (const float*)(w_ + WS_ROPE); bf16* Q = (bf16*)(w_ + B_Q);
        const float r = QSCALE * rsqf_(rss[row] * (1.f / 256.f) + EPS);
        v0 = v0 * r; v1 = v1 * r;
        if (col < 512) { const int h = col >> 6, d = col & 63; *(u32x4*)(Q + (size_t)row * 768 + h * 96 + d) = pack8(v0, v1); }
        else { const int c = col - 512, h = c >> 5, i0 = ((c & 31) >> 3) * 4;
            f32x4 o1 = v0, o2 = v1;
            if (row < NLAT) { const float* cs = rope + ((size_t)(row & 2047) * 16 + i0) * 2;
#pragma unroll
                for (int j = 0; j < 4; ++j) { const float c_ = cs[2 * j], s_ = cs[2 * j + 1]; o1[j] = v0[j] * c_ - v1[j] * s_; o2[j] = v0[j] * s_ + v1[j] * c_; } }
            bf16* q = Q + (size_t)row * 768 + h * 96 + 64 + i0; u32x2 w1, w2; w1.x = pk2(o1[0], o1[1]); w1.y = pk2(o1[2], o1[3]); w2.x = pk2(o2[0], o2[1]); w2.y = pk2(o2[2], o2[3]);
            *(u32x2*)q = w1; *(u32x2*)(q + 16) = w2; }
    } };

struct EpiInA {
    static constexpr bool PERM = true, AFTER_DRAIN = false;
    int row_off; unsigned char* ws; const float* dtb_;
    __device__ __forceinline__ void operator()(const f32x4 (&acc)[2][2][4][2], const pg8::Unit& u, int wr, int wc, int fr, int fq) const {
        asm volatile("" : "+v"(fr), "+v"(fq));
        const int pn = u.pn; unsigned char* w_ = ws; const float* dtb = dtb_;
        bf16* KVR = (bf16*)(w_ + B_KVR); bf16* KRP = (bf16*)(w_ + B_KRP); bf16* XBCR = (bf16*)(w_ + B_XBCR); bf16* QLAT = (bf16*)(w_ + B_QLAT); bf16* SZ = (bf16*)(w_ + B_SZ); bf16* UV = (bf16*)(w_ + B_UV);
        float* DT = (float*)(w_ + B_DT); float* RSSKV = (float*)(w_ + WS_STAT); float* RSSQ = RSSKV + NTOK; float* VSUM = RSSKV + 2 * NTOK; float* VSQ = RSSKV + 3 * NTOK; const float* rope = (const float*)(w_ + WS_ROPE);
#pragma unroll
        for (int ai = 0; ai < 2; ++ai)
#pragma unroll
            for (int m = 0; m < 4; ++m) {
                const int row = row_off + u.pm * 256 + ai * 128 + wr * 64 + m * 16 + fr;
                const int cw = wc * 32 + 8 * fq;
                if (pn == 0) {
                    const f32x4 v0 = acc[ai][0][m][0], v1 = acc[ai][0][m][1], w0 = acc[ai][1][m][0], w1 = acc[ai][1][m][1];
                    *(u32x4*)(KVR + (size_t)row * 256 + cw) = pack8(v0, v1);
                    *(u32x4*)(KVR + (size_t)row * 256 + 128 + cw) = pack8(w0, w1);
                    float ss = (v0[0] * v0[0] + v0[1] * v0[1]) + (v0[2] * v0[2] + v0[3] * v0[3]) + (v1[0] * v1[0] + v1[1] * v1[1]) + (v1[2] * v1[2] + v1[3] * v1[3]);
                    ss += __shfl_xor(ss, 16); ss += __shfl_xor(ss, 32);
                    if (fq == 0) atomicAdd(RSSKV + row, ss);
                    if (wc == 0) {
                        f32x4 o1 = w0, o2 = w1; const int i0 = 4 * fq;
                        if (row < NLAT) { const float* cs = rope + ((size_t)(row & 2047) * 16 + i0) * 2;
#pragma unroll
                            for (int j = 0; j < 4; ++j) { const float c_ = cs[2 * j], s_ = cs[2 * j + 1]; o1[j] = w0[j] * c_ - w1[j] * s_; o2[j] = w0[j] * s_ + w1[j] * c_; } }
                        u32x2 a, b; a.x = pk2(o1[0], o1[1]); a.y = pk2(o1[2], o1[3]); b.x = pk2(o2[0], o2[1]); b.y = pk2(o2[2], o2[3]);
                        *(u32x2*)(KRP + (size_t)row * 32 + i0) = a; *(u32x2*)(KRP + (size_t)row * 32 + 16 + i0) = b;
                    } else if (wc == 1 && fq < 2) {
                        f32x4 d0, d1;
#pragma unroll
                        for (int j = 0; j < 4; ++j) { d0[j] = softplusf_(w0[j] + dtb[fq * 8 + j]); d1[j] = softplusf_(w1[j] + dtb[fq * 8 + 4 + j]); }
                        *(f32x4*)(DT + (size_t)row * 16 + fq * 8) = d0; *(f32x4*)(DT + (size_t)row * 16 + fq * 8 + 4) = d1;
                    }
                } else if (pn <= 4) {
#pragma unroll
                    for (int bj = 0; bj < 2; ++bj) *(u32x4*)(XBCR + (size_t)row * 1024 + (pn - 1) * 256 + bj * 128 + cw) = pack8(acc[ai][bj][m][0], acc[ai][bj][m][1]);
                } else if (pn == 5) {
                    float ss = 0.f;
#pragma unroll
                    for (int bj = 0; bj < 2; ++bj) { const f32x4 v0 = acc[ai][bj][m][0], v1 = acc[ai][bj][m][1];
                        *(u32x4*)(QLAT + (size_t)row * 256 + bj * 128 + cw) = pack8(v0, v1);
                        ss += (v0[0] * v0[0] + v0[1] * v0[1]) + (v0[2] * v0[2] + v0[3] * v0[3]) + (v1[0] * v1[0] + v1[1] * v1[1]) + (v1[2] * v1[2] + v1[3] * v1[3]); }
                    ss += __shfl_xor(ss, 16); ss += __shfl_xor(ss, 32);
                    if (fq == 0) atomicAdd(RSSQ + row, ss);
                } else if (pn <= 7) {
#pragma unroll
                    for (int bj = 0; bj < 2; ++bj) { f32x4 a0, a1;
#pragma unroll
                        for (int j = 0; j < 4; ++j) { a0[j] = siluf_(acc[ai][bj][m][0][j]); a1[j] = siluf_(acc[ai][bj][m][1][j]); }
                        *(u32x4*)(SZ + (size_t)row * 512 + (pn - 6) * 256 + bj * 128 + cw) = pack8(a0, a1); }
                } else {
                    float s = 0.f, ss = 0.f;
#pragma unroll
                    for (int bj = 0; bj < 2; ++bj) { f32x4 a0, a1;
#pragma unroll
                        for (int j = 0; j < 4; ++j) { a0[j] = gelu_tanh(acc[ai][bj][m][0][j]); a1[j] = gelu_tanh(acc[ai][bj][m][1][j]); s += a0[j] + a1[j]; ss += a0[j] * a0[j] + a1[j] * a1[j]; }
                        *(u32x4*)(UV + (size_t)row * 1024 + (pn - 8) * 256 + bj * 128 + cw) = pack8(a0, a1); }
                    if (pn >= 10) { s += __shfl_xor(s, 16); s += __shfl_xor(s, 32); ss += __shfl_xor(ss, 16); ss += __shfl_xor(ss, 32);
                        if (fq == 0) { atomicAdd(VSUM + row, s); atomicAdd(VSQ + row, ss); } }
                }
            }
    }
};

typedef __attribute__((address_space(3))) const char* lds_cptr;
typedef short v4i16_t __attribute__((ext_vector_type(4)));
typedef short s16x4 __attribute__((ext_vector_type(4)));
__device__ __forceinline__ s16x4 vtr(lds_cptr p) { return __builtin_bit_cast(s16x4, __builtin_amdgcn_ds_read_tr16_b64_v4i16((__attribute__((address_space(3))) v4i16_t*)p)); }
__device__ __forceinline__ int crow(int r, int hi) { return (r & 3) + 8 * (r >> 2) + 4 * hi; }

__device__ __forceinline__ void attn_unit(const Frame& F, int h, int qrow0, int seg0_row, int seg0_tiles, int seg1_row, int seg1_tiles) {
    const bf16* Q = WSP(bf16, B_Q); const bf16* KN = WSP(bf16, B_KN); const bf16* KRP = WSP(bf16, B_KRP); const bf16* V = WSP(bf16, B_V); bf16* AO = WSP(bf16, B_AMLA);
    const int tid = F.tid, lane = F.lane, wid = F.wave, r32 = lane & 31, hi = lane >> 5;
    LAS unsigned char* KT = F.lds; LAS unsigned char* VT = F.lds + 13312; LAS float* wsf = (LAS float*)(F.lds + 21504) + wid * 64;
    bf16x8 qr[6];
    { const bf16* qp = Q + (size_t)(qrow0 + wid * 32 + r32) * 768 + h * 96 + hi * 8;
#pragma unroll
      for (int d0 = 0; d0 < 6; ++d0) qr[d0] = *(const bf16x8*)(qp + d0 * 16); }
    f32x16 o0 = {}, o1 = {};
    float m_run = -1e30f, l_run = 0.f;
    const int NT = seg0_tiles + seg1_tiles;
    const int skey = tid >> 3, sch = tid & 7, rkey = tid >> 2, rch = tid & 3;
    u32x4 kn_r, kr_r = (u32x4){0u, 0u, 0u, 0u}, v_r;
    { const int rb = seg0_tiles > 0 ? seg0_row : seg1_row;
      kn_r = *(const u32x4*)(KN + (size_t)(rb + skey) * 512 + h * 64 + sch * 8); v_r = *(const u32x4*)(V + (size_t)(rb + skey) * 512 + h * 64 + sch * 8);
      if (tid < 256) kr_r = *(const u32x4*)(KRP + (size_t)(rb + rkey) * 32 + rch * 8); }
    const lds_cptr vp0 = (lds_cptr)VT + ((lane >> 4) & 1) * 32 + (lane & 3) * 8 + (4 * hi + ((lane & 15) >> 2)) * 64;
    for (int t = 0; t < NT; ++t) {
        __syncthreads();
        *(LAS u32x4*)(KT + skey * 208 + sch * 16) = kn_r;
        if (tid < 256) *(LAS u32x4*)(KT + rkey * 208 + 128 + rch * 16) = kr_r;
        *(LAS u32x4*)(VT + (sch >> 2) * 4096 + skey * 64 + (sch & 3) * 16) = v_r;
        __syncthreads();
        if (t + 1 < NT) { const int t1 = t + 1; const int rb = t1 < seg0_tiles ? seg0_row + t1 * 64 : seg1_row + (t1 - seg0_tiles) * 64;
            kn_r = *(const u32x4*)(KN + (size_t)(rb + skey) * 512 + h * 64 + sch * 8); v_r = *(const u32x4*)(V + (size_t)(rb + skey) * 512 + h * 64 + sch * 8);
            if (tid < 256) kr_r = *(const u32x4*)(KRP + (size_t)(rb + rkey) * 32 + rch * 8); }
        f32x16 p0 = {}, p1 = {};
#pragma unroll
        for (int d0 = 0; d0 < 6; ++d0) {
            const bf16x8 a0 = *(const LAS bf16x8*)(KT + r32 * 208 + d0 * 32 + hi * 16);
            const bf16x8 a1 = *(const LAS bf16x8*)(KT + (r32 + 32) * 208 + d0 * 32 + hi * 16);
            p0 = __builtin_amdgcn_mfma_f32_32x32x16_bf16(a0, qr[d0], p0, 0, 0, 0);
            p1 = __builtin_amdgcn_mfma_f32_32x32x16_bf16(a1, qr[d0], p1, 0, 0, 0);
        }
        float mx = p0[0];
#pragma unroll
        for (int r = 0; r < 16; ++r) { mx = fmaxf(mx, p0[r]); mx = fmaxf(mx, p1[r]); }
        mx = fmaxf(mx, __shfl_xor(mx, 32));
        const float mnew = fmaxf(m_run, mx), alpha = exp2f(m_run - mnew); m_run = mnew;
        float ps = 0.f;
#pragma unroll
        for (int r = 0; r < 16; ++r) { p0[r] = exp2f(p0[r] - mnew); p1[r] = exp2f(p1[r] - mnew); ps += p0[r] + p1[r]; }
        l_run = l_run * alpha + ps;
        if (hi == 0) wsf[r32] = alpha;
        asm volatile("s_waitcnt lgkmcnt(0)" ::: "memory");
#pragma unroll
        for (int q4 = 0; q4 < 4; ++q4) { const f32x4 al = *(const LAS f32x4*)(wsf + 8 * q4 + 4 * hi);
#pragma unroll
            for (int j = 0; j < 4; ++j) { o0[4 * q4 + j] *= al[j]; o1[4 * q4 + j] *= al[j]; } }
        u32x4 pw[4];
        pw[0] = (u32x4){pk2(p0[0], p0[1]), pk2(p0[2], p0[3]), pk2(p0[4], p0[5]), pk2(p0[6], p0[7])};
        pw[1] = (u32x4){pk2(p0[8], p0[9]), pk2(p0[10], p0[11]), pk2(p0[12], p0[13]), pk2(p0[14], p0[15])};
        pw[2] = (u32x4){pk2(p1[0], p1[1]), pk2(p1[2], p1[3]), pk2(p1[4], p1[5]), pk2(p1[6], p1[7])};
        pw[3] = (u32x4){pk2(p1[8], p1[9]), pk2(p1[10], p1[11]), pk2(p1[12], p1[13]), pk2(p1[14], p1[15])};
#pragma unroll
        for (int ks = 0; ks < 4; ++ks) {
            const s16x4 l0 = vtr(vp0 + ks * 1024), h0 = vtr(vp0 + ks * 1024 + 512), l1 = vtr(vp0 + 4096 + ks * 1024), h1 = vtr(vp0 + 4096 + ks * 1024 + 512);
            const bf16x8 b0 = (bf16x8){l0[0], l0[1], l0[2], l0[3], h0[0], h0[1], h0[2], h0[3]}, b1 = (bf16x8){l1[0], l1[1], l1[2], l1[3], h1[0], h1[1], h1[2], h1[3]};
            const bf16x8 pa = __builtin_bit_cast(bf16x8, pw[ks]);
            o0 = __builtin_amdgcn_mfma_f32_32x32x16_bf16(pa, b0, o0, 0, 0, 0);
            o1 = __builtin_amdgcn_mfma_f32_32x32x16_bf16(pa, b1, o1, 0, 0, 0);
        }
    }
    l_run += __shfl_xor(l_run, 32);
    if (hi == 0) wsf[32 + r32] = 1.0f / l_run;
    asm volatile("s_waitcnt lgkmcnt(0)" ::: "memory");
    bf16* ao = AO + (size_t)(qrow0 + wid * 32) * 512 + h * 64 + r32;
#pragma unroll
    for (int q4 = 0; q4 < 4; ++q4) { const f32x4 il = *(const LAS f32x4*)(wsf + 32 + 8 * q4 + 4 * hi);
#pragma unroll
        for (int j = 0; j < 4; ++j) { const int r = 4 * q4 + j, qq = crow(r, hi); ao[(size_t)qq * 512] = f2bf(o0[r] * il[j]); ao[(size_t)qq * 512 + 32] = f2bf(o1[r] * il[j]); } }
}

__device__ __forceinline__ f32x4 mfma16(bf16x8 a, bf16x8 b, f32x4 c) { return __builtin_amdgcn_mfma_f32_16x16x32_bf16(a, b, c, 0, 0, 0); }
__device__ __forceinline__ void ssd_unit(const Frame& F, int l, int b, int dir, int h, bool ctx_y) {
    const bf16* XBC = WSP(bf16, B_XBC); const float* DT = WSP(float, B_DT); bf16* Y = dir == 0 ? WSP(bf16, B_YF) : WSP(bf16, B_YB);
    const int tid = F.tid, lane = F.lane, wid = F.wave, l15 = lane & 15, l4 = lane >> 4, g = h >> 2;
    constexpr int P = 136;
    unsigned oB = 34816, oW = 69632, oX = 104448, oH = 121856, oA = 139264;
    asm volatile("" : "+s"(oB), "+s"(oW), "+s"(oX), "+s"(oH), "+s"(oA));
    LAS bf16* CS = (LAS bf16*)(F.lds); LAS bf16* BS = (LAS bf16*)(F.lds + oB); LAS bf16* BWT = (LAS bf16*)(F.lds + oW); LAS bf16* XT = (LAS bf16*)(F.lds + oX); LAS bf16* HS = (LAS bf16*)(F.lds + oH);
    LAS float* ACU = (LAS float*)(F.lds + oA); LAS float* DTV = ACU + 128; LAS float* WQ = ACU + 256; LAS float* ATOT = ACU + 384;
    const float Acoef = -__expf(INP(I_ALOG)[(l * 2 + dir) * 8 + h]); const float Dh = INP(I_SSMD)[l * 8 + h];
    f32x4 hst[4];
#pragma unroll
    for (int pt = 0; pt < 4; ++pt) hst[pt] = (f32x4){0.f, 0.f, 0.f, 0.f};
    __syncthreads();
    for (int i = tid; i < 64 * P / 2; i += NTHR) ((LAS unsigned*)HS)[i] = 0u;
    for (int step = 0; step < 18; ++step) {
        const bool isctx = step < 2; const int ci = isctx ? (dir == 0 ? step : 1 - step) : (dir == 0 ? step - 2 : 17 - step);
        const int R0 = isctx ? NLAT + b * CTXL + ci * 128 : b * SEQ + ci * 128;
        const bool need_y = !isctx || ctx_y;
        if (wid == 0) {
            const int q0 = dir ? 127 - 2 * lane : 2 * lane, q1 = dir ? 126 - 2 * lane : 2 * lane + 1;
            const float d0 = DT[(size_t)(R0 + q0) * 16 + dir * 8 + h], d1 = DT[(size_t)(R0 + q1) * 16 + dir * 8 + h];
            const float a0 = d0 * Acoef, a1 = d1 * Acoef, s = a0 + a1; float incl = s;
#pragma unroll
            for (int off = 1; off < 64; off <<= 1) { const float t = __shfl_up(incl, off); if (lane >= off) incl += t; }
            const float excl = incl - s, c0 = excl + a0, c1 = incl, atot = __shfl(incl, 63);
            ACU[q0] = c0; ACU[q1] = c1; DTV[q0] = d0; DTV[q1] = d1; WQ[q0] = __expf(atot - c0) * d0; WQ[q1] = __expf(atot - c1) * d1;
            if (lane == 0) ATOT[0] = atot;
        }
#pragma unroll
        for (int i = 0; i < 4; ++i) { const int piece = tid + NTHR * i, row = piece >> 4, ch = piece & 15;
            const u32x4 cv = *(const u32x4*)(XBC + (size_t)(R0 + row) * 1024 + 768 + g * 128 + ch * 8);
            const u32x4 bv = *(const u32x4*)(XBC + (size_t)(R0 + row) * 1024 + 512 + g * 128 + ch * 8);
            *(LAS u32x4*)(CS + row * P + ch * 8) = cv; *(LAS u32x4*)(BS + row * P + ch * 8) = bv; }
#pragma unroll
        for (int i = 0; i < 2; ++i) { const int piece = tid + NTHR * i, q = piece & 127, ch = piece >> 7;
            const u32x4 xv = *(const u32x4*)(XBC + (size_t)(R0 + q) * 1024 + h * 64 + ch * 8);
            const unsigned short* e = (const unsigned short*)&xv;
#pragma unroll
            for (int j = 0; j < 8; ++j) XT[(ch * 8 + j) * P + q] = e[j]; }
        __syncthreads();
#pragma unroll
        for (int i = 0; i < 4; ++i) { const int piece = tid + NTHR * i, q = piece & 127, nch = piece >> 7;
            const u32x4 bv = *(const LAS u32x4*)(BS + q * P + nch * 8); float f[8]; unpack8(bv, f); const float wq = WQ[q];
#pragma unroll
            for (int j = 0; j < 8; ++j) BWT[(nch * 8 + j) * P + q] = f2bf(f[j] * wq); }
        bf16x8 ca[4];
#pragma unroll
        for (int kk = 0; kk < 4; ++kk) ca[kk] = *(const LAS bf16x8*)(CS + (16 * wid + l15) * P + kk * 32 + l4 * 8);
        f32x4 G[8];
        if (need_y) {
#pragma unroll
            for (int jt = 0; jt < 8; ++jt) { f32x4 a = (f32x4){0.f, 0.f, 0.f, 0.f};
#pragma unroll
                for (int kk = 0; kk < 4; ++kk) { const bf16x8 bb = *(const LAS bf16x8*)(BS + (16 * jt + l15) * P + kk * 32 + l4 * 8); a = mfma16(ca[kk], bb, a); }
                G[jt] = a; }
        }
        __syncthreads();
        if (need_y) {
            float ai[4];
#pragma unroll
            for (int r = 0; r < 4; ++r) ai[r] = ACU[16 * wid + 4 * l4 + r];
            LAS bf16* SS = BS;
            int ibase = 16 * wid + 4 * l4, jbase = l15; asm volatile("" : "+v"(ibase), "+v"(jbase));
#pragma unroll
            for (int jt = 0; jt < 8; ++jt) { const int j = 16 * jt + jbase; const float aj = ACU[j], dj = DTV[j];
#pragma unroll
                for (int r = 0; r < 4; ++r) { const int i = ibase + r; const bool valid = dir == 0 ? (j <= i) : (j >= i);
                    const float v = valid ? G[jt][r] * __expf(ai[r] - aj) * dj : 0.f; SS[i * P + j] = f2bf(v); } }
            asm volatile("s_waitcnt lgkmcnt(0)" ::: "memory");
            bf16x8 sa[4];
#pragma unroll
            for (int kk = 0; kk < 4; ++kk) sa[kk] = *(const LAS bf16x8*)(SS + (16 * wid + l15) * P + kk * 32 + l4 * 8);
#pragma unroll
            for (int pt = 0; pt < 4; ++pt) { f32x4 yi = (f32x4){0.f, 0.f, 0.f, 0.f}, ye = (f32x4){0.f, 0.f, 0.f, 0.f};
#pragma unroll
                for (int kk = 0; kk < 4; ++kk) { const bf16x8 bx = *(const LAS bf16x8*)(XT + (16 * pt + l15) * P + kk * 32 + l4 * 8); yi = mfma16(sa[kk], bx, yi);
                    const bf16x8 bh = *(const LAS bf16x8*)(HS + (16 * pt + l15) * P + kk * 32 + l4 * 8); ye = mfma16(ca[kk], bh, ye); }
                const int p = 16 * pt + l15;
#pragma unroll
                for (int r = 0; r < 4; ++r) { const int i = 16 * wid + 4 * l4 + r; float y = yi[r] + __expf(ai[r]) * ye[r];
                    if (dir == 0) y += Dh * bf2f(XT[p * P + i]);
                    Y[(size_t)(R0 + i) * 512 + h * 64 + p] = f2bf(y); } }
        }
        __syncthreads();
        {
            const float decay = __expf(ATOT[0]);
            bf16x8 bw[4];
#pragma unroll
            for (int kk = 0; kk < 4; ++kk) bw[kk] = *(const LAS bf16x8*)(BWT + (16 * wid + l15) * P + kk * 32 + l4 * 8);
#pragma unroll
            for (int pt = 0; pt < 4; ++pt) { f32x4 a = hst[pt] * decay;
#pragma unroll
                for (int kk = 0; kk < 4; ++kk) { const bf16x8 ax = *(const LAS bf16x8*)(XT + (16 * pt + l15) * P + kk * 32 + l4 * 8); a = mfma16(ax, bw[kk], a); }
                hst[pt] = a;
#pragma unroll
                for (int r = 0; r < 4; ++r) HS[(16 * pt + 4 * l4 + r) * P + 16 * wid + l15] = f2bf(a[r]); }
        }
        __syncthreads();
    }
}

__device__ __forceinline__ void gmlp_unit(const Frame& F, int l, int R0, int g) {
    constexpr int P = 136;
    LAS bf16* WSm = (LAS bf16*)(F.lds); LAS bf16* VT = (LAS bf16*)(F.lds + 34816);
    bf16* UV = WSP(bf16, B_UV); const float* VSUM = WSP(float, WS_STAT) + 2 * NTOK; const float* VSQ = WSP(float, WS_STAT) + 3 * NTOK;
    const bf16* Wg = WGT(W_GS) + (size_t)g * 128 * 128; const float* gn = INP(I_GMNORM) + l * 512 + g * 64; const float* bs = INP(I_GMBS) + (l * 8 + g) * 128;
    const int tid = F.tid, lane = F.lane, wid = F.wave, l15 = lane & 15, l4 = lane >> 4;
    __syncthreads();
#pragma unroll
    for (int i = 0; i < 4; ++i) { const int piece = tid + NTHR * i, row = piece >> 4, ch = piece & 15; *(LAS u32x4*)(WSm + row * P + ch * 8) = *(const u32x4*)(Wg + row * 128 + ch * 8); }
#pragma unroll
    for (int i = 0; i < 2; ++i) { const int piece = tid + NTHR * i, j = piece & 127, ch = piece >> 7;
        const u32x4 vv = *(const u32x4*)(UV + (size_t)(R0 + j) * 1024 + 512 + g * 64 + ch * 8); float f[8]; unpack8(vv, f);
        const float mean = VSUM[R0 + j] * (1.f / 512.f); const float var = fmaxf(VSQ[R0 + j] * (1.f / 512.f) - mean * mean, 0.f); const float rstd = 1.0f / sqrtf(var + EPS);
#pragma unroll
        for (int e = 0; e < 8; ++e) VT[(ch * 8 + e) * P + j] = f2bf((f[e] - mean) * rstd * gn[ch * 8 + e]); }
    __syncthreads();
    bf16x8 a[4];
#pragma unroll
    for (int kk = 0; kk < 4; ++kk) a[kk] = *(const LAS bf16x8*)(WSm + (16 * wid + l15) * P + kk * 32 + l4 * 8);
#pragma unroll
    for (int dt = 0; dt < 4; ++dt) { f32x4 acc = (f32x4){0.f, 0.f, 0.f, 0.f};
#pragma unroll
        for (int kk = 0; kk < 4; ++kk) { const bf16x8 bb = *(const LAS bf16x8*)(VT + (16 * dt + l15) * P + kk * 32 + l4 * 8); acc = mfma16(a[kk], bb, acc); }
        const int d = 16 * dt + l15;
#pragma unroll
        for (int r = 0; r < 4; ++r) { const int i = 16 * wid + 4 * l4 + r; bf16* up = UV + (size_t)(R0 + i) * 1024 + g * 64 + d; *up = f2bf(bf2f(*up) * (acc[r] + bs[i])); } }
}

constexpr int PH_PER_LAYER = 13, N_PHASES = 1 + 2 * PH_PER_LAYER + 1;

__global__ void __launch_bounds__(NTHR, 2) mk_fwd(Args args) {
    extern __shared__ __attribute__((aligned(16))) unsigned char lds_raw[];
    Frame F;
    F.lds = (LAS unsigned char*)lds_raw;
    F.tid = threadIdx.x; F.lane = F.tid & 63; F.wave = __builtin_amdgcn_readfirstlane(F.tid >> 6);
    F.G = gridDim.x; F.bid = blockIdx.x; F.vcu = F.bid; F.z = 0;
    F.in = args.in; F.out = args.out; F.ws = args.ws;
    volatile LAS unsigned* MISC = (volatile LAS unsigned*)(F.lds + MISC_OFF);
    if (F.tid < 64) MISC[F.tid] = 0u;
    __syncthreads();
    unsigned* ctl = WSP(unsigned, WS_CTL);
    XcdBarrier bar; bar.bar = ctl + CW_BAR; bar.x = 0; bar.st = nullptr;
#if !MK_PER_PHASE
    bar = xcd_barrier_post(ctl + CW_BAR, MISC + 8);
#endif
    const int lo = args.ph_lo, hi = args.ph_hi;
#ifndef PHMASK
#define PHMASK 0xFFFFu
#endif
#define IN(k) (lo <= (k) && (k) < hi)
#define PM(i) (((PHMASK) >> (i)) & 1u)
#define PHASE_BEGIN() do { F.z = 0; asm volatile("" : "+s"(F.z)); asm volatile("" : "+s"(lq)); asm volatile("" : "+v"(F.tid)); F.lane = F.tid & 63; \
        F.G = (int)gridDim.x + (int)F.z; F.bid = (int)blockIdx.x + (int)F.z; F.vcu = (F.G % 8 == 0) ? (F.bid % 8) * (F.G / 8) + F.bid / 8 : F.bid; } while (0)
#ifndef MXMASK
#define MXMASK 0xFFu
#endif
#define MX(i) (((MXMASK) >> (i)) & 1u)
#if MK_PER_PHASE
#define SEAM(k) do {} while (0)
#else
#define SEAM(k) do { if (IN(k) && IN((k) + 1)) xcd_barrier(bar); } while (0)
#endif
    LAS unsigned char* glds = F.lds;
    const float* MOD = WSP(float, WS_MOD);

    int lq = 0;
    if (PM(13) && IN(0)) { PHASE_BEGIN(); prologue_mod(F); __syncthreads(); convert_weights(F, 0); }
    SEAM(0);
#pragma clang loop unroll(disable)
    for (int l = 0; l < 2; ++l) {
        const int pb = 1 + PH_PER_LAYER * l; const bool last = (l == 1); int lq = l;
#define modl (MOD + (size_t)lq * 9 * MODW)
        if (PM(0) && IN(pb + 0)) { PHASE_BEGIN(); if (lq > 0) convert_weights(F, lq); norm_phase(F, lq, 0, lq == 0, NTOK); }
        SEAM(pb + 0);
        if (PM(1) && IN(pb + 1)) { PHASE_BEGIN(); pg8::Gemm g{WSP(bf16, WS_H), WGT(W_F1I), NTOK, 2 * DFF, DM, DM, DM}; pg8::StaticOrder S; S.init(NTOK, 2 * DFF, F.G, F.bid);
            pg8::EpiGU<FSwiglu> E{FSwiglu{WSP(bf16, B_ACT)}}; pg8::gemm_phase<pg8::EpiGU<FSwiglu>, pg8::StaticOrder, true, true>(glds, g, S, E); }
        SEAM(pb + 1);
        if (PM(2) && IN(pb + 2)) { PHASE_BEGIN(); pg8::Gemm g{WSP(bf16, B_ACT), WGT(W_F1O), NTOK, DM, DFF, DFF, DFF}; pg8::StaticOrder S; S.init(NTOK, DM, F.G, F.bid);
            pg8::Epi4<FResid> E{FResid{INP(I_X), INP(I_CTX), OUTP, WSP(float, WS_XCTX), modl, 2, 0.5f, lq == 0 ? 1 : 0}}; pg8::gemm_phase<pg8::Epi4<FResid>, pg8::StaticOrder, true, true>(glds, g, S, E); }
        SEAM(pb + 2);
        if (PM(3) && IN(pb + 3)) { PHASE_BEGIN(); norm_phase(F, lq, 1, false, NTOK); zero_stats(F); }
        SEAM(pb + 3);
        if (PM(4) && IN(pb + 4)) { PHASE_BEGIN();
            EpiInA E{0, F.ws, INP(I_DTBIAS) + lq * 16};
            if (!last) { pg8::Gemm g{WSP(bf16, WS_H), WGT(W_INA), NTOK, 3072, DM, DM, DM}; pg8::StaticOrder S; S.init(NTOK, 3072, F.G, F.bid); pg8::gemm_phase<EpiInA, pg8::StaticOrder, true, true>(glds, g, S, E); }
            else { { pg8::Gemm g{WSP(bf16, WS_H), WGT(W_INA), NLAT, 3072, DM, DM, DM}; pg8::StaticOrder S; S.init(NLAT, 3072, F.G, F.bid); pg8::gemm_phase<EpiInA, pg8::StaticOrder, true, true>(glds, g, S, E); }
                   { E.row_off = NLAT; pg8::Gemm g{WSP(bf16, WS_H) + (size_t)NLAT * DM, WGT(W_INA), NCTX, 1280, DM, DM, DM}; pg8::StaticOrder S; S.init(NCTX, 1280, F.G, (int)((F.bid + 128) % F.G)); pg8::gemm_phase<EpiInA, pg8::StaticOrder, true, true>(glds, g, S, E); } }
        }
        SEAM(pb + 4);
        if (PM(5) && IN(pb + 5)) { PHASE_BEGIN();
            if (MX(3)) { pg8::Gemm g{WSP(bf16, B_KVR), WGT(W_UKV), NTOK, 1024, 256, 256, 256}; pg8::StaticOrder S; S.init(NTOK, 1024, F.G, F.bid);
              pg8::Epi8<FKvUp> E{FKvUp{F.ws}}; pg8::gemm_phase<pg8::Epi8<FKvUp>, pg8::StaticOrder, true, true>(glds, g, S, E); }
            if (MX(4)) { const int M = last ? NLAT : NTOK; pg8::Gemm g{WSP(bf16, B_QLAT), WGT(W_UQ), M, 768, 256, 256, 256}; pg8::StaticOrder S; S.init(M, 768, F.G, (int)((F.bid + 32) % F.G));
              pg8::Epi8<FQUp> E{FQUp{F.ws}}; pg8::gemm_phase<pg8::Epi8<FQUp>, pg8::StaticOrder, true, true>(glds, g, S, E); }
            if (MX(5)) conv_phase(F, lq, NTOK);
        }
        SEAM(pb + 5);
        if (PM(6) && IN(pb + 6)) { PHASE_BEGIN();
            const int nssd = 128, natt = 512 + (last ? 0 : 64), ngm = 1024 + (last ? 0 : 128), ntot = nssd + natt + ngm;
            unsigned* head = ctl + CW_QUEUE + 64 * lq;
            for (;;) {
                __syncthreads();
                if (F.tid == 0) MISC[0] = __hip_atomic_fetch_add(head, 1u, __ATOMIC_RELAXED, __HIP_MEMORY_SCOPE_AGENT);
                __syncthreads();
                int u = (int)MISC[0];
                if (u >= ntot) break;
                if (u < nssd) { if (MX(0)) ssd_unit(F, lq, u >> 4, (u >> 3) & 1, u & 7, !last); }
                else if (u < nssd + natt) { u -= nssd;
                    if (u < 512) { const int b = u >> 6, h = (u >> 3) & 7, qb = u & 7; if (MX(1)) attn_unit(F, h, b * SEQ + qb * 256, b * SEQ, 32, NLAT + b * CTXL, 4); }
                    else { u -= 512; const int b = u >> 3, h = u & 7; if (MX(1)) attn_unit(F, h, NLAT + b * CTXL, NLAT + b * CTXL, 4, 0, 0); } }
                else { u -= nssd + natt;
                    if (u < 1024) { const int b = u >> 7, c = (u >> 3) & 15, g = u & 7; if (MX(2)) gmlp_unit(F, lq, b * SEQ + c * 128, g); }
                    else { u -= 1024; const int b = u >> 4, c = (u >> 3) & 1, g = u & 7; if (MX(2)) gmlp_unit(F, lq, NLAT + b * CTXL + c * 128, g); } }
            }
        }
        SEAM(pb + 6);
        const int MR = last ? NLAT : NTOK;
        if (PM(7) && IN(pb + 7)) { PHASE_BEGIN();
            ssm_out_prep(F, lq, MR);
            pg8::Gemm g{WSP(bf16, WS_H), WGT(W_GATE), MR, 3072, DM, DM, DM}; pg8::StaticOrder S; S.init(MR, 3072, F.G, F.bid);
            pg8::Epi8<FGates> E{FGates{WSP(bf16, B_GATES), INP(I_BGATE) + lq * 3072}}; pg8::gemm_phase<pg8::Epi8<FGates>, pg8::StaticOrder, true, true>(glds, g, S, E);
        }
        SEAM(pb + 7);
        if (PM(8) && IN(pb + 8)) { PHASE_BEGIN();
            pg8::StaticOrder S; S.init(MR, DM, F.G, F.bid);
            { pg8::Gemm g{WSP(bf16, B_AMLA), WGT(W_MO), MR, DM, 512, 512, 512}; pg8::Epi8<FMerge> E{FMerge{WSP(bf16, B_GATES), WSP(bf16, WS_H), 0}}; pg8::gemm_phase<pg8::Epi8<FMerge>, pg8::StaticOrder, true, true>(glds, g, S, E); }
            { pg8::Gemm g{WSP(bf16, B_YF), WGT(W_SO), MR, DM, 512, 512, 512}; pg8::Epi8<FMerge> E{FMerge{WSP(bf16, B_GATES), WSP(bf16, WS_H), 1}}; pg8::gemm_phase<pg8::Epi8<FMerge>, pg8::StaticOrder, true, true>(glds, g, S, E); }
            { pg8::Gemm g{WSP(bf16, B_UV), WGT(W_GO), MR, DM, 512, 1024, 512}; pg8::Epi8<FMerge> E{FMerge{WSP(bf16, B_GATES), WSP(bf16, WS_H), 2}}; pg8::gemm_phase<pg8::Epi8<FMerge>, pg8::StaticOrder, true, true>(glds, g, S, E); }
        }
        SEAM(pb + 8);
        if (PM(9) && IN(pb + 9)) { PHASE_BEGIN(); pg8::Gemm g{WSP(bf16, WS_H), WGT(W_OUT), MR, DM, DM, DM, DM}; pg8::StaticOrder S; S.init(MR, DM, F.G, F.bid);
            pg8::Epi4<FResid> E{FResid{INP(I_X), INP(I_CTX), OUTP, WSP(float, WS_XCTX), modl, 5, 1.0f, 0}}; pg8::gemm_phase<pg8::Epi4<FResid>, pg8::StaticOrder, true, true>(glds, g, S, E); }
        SEAM(pb + 9);
        if (PM(10) && IN(pb + 10)) { PHASE_BEGIN(); norm_phase(F, lq, 2, false, MR); }
        SEAM(pb + 10);
        if (PM(11) && IN(pb + 11)) { PHASE_BEGIN(); pg8::Gemm g{WSP(bf16, WS_H), WGT(W_F2I), MR, 2 * DFF, DM, DM, DM}; pg8::StaticOrder S; S.init(MR, 2 * DFF, F.G, F.bid);
            pg8::EpiGU<FSwiglu> E{FSwiglu{WSP(bf16, B_ACT)}}; pg8::gemm_phase<pg8::EpiGU<FSwiglu>, pg8::StaticOrder, true, true>(glds, g, S, E); }
        SEAM(pb + 11);
        if (PM(12) && IN(pb + 12)) { PHASE_BEGIN(); pg8::Gemm g{WSP(bf16, B_ACT), WGT(W_F2O), MR, DM, DFF, DFF, DFF}; pg8::StaticOrder S; S.init(MR, DM, F.G, F.bid);
            pg8::Epi4<FResid> E{FResid{INP(I_X), INP(I_CTX), OUTP, WSP(float, WS_XCTX), modl, 8, 0.5f, 0}}; pg8::gemm_phase<pg8::Epi4<FResid>, pg8::StaticOrder, true, true>(glds, g, S, E); }
        SEAM(pb + 12);
    }
#undef modl
    if (PM(14) && IN(N_PHASES - 1)) { PHASE_BEGIN(); final_norm(F); }
#undef IN
#undef SEAM
}

extern "C" void kernel_launch(void* const* d_in, const int* in_sizes, int n_in, void* d_out, int out_size, void* d_ws, size_t ws_size, hipStream_t stream) {
    static int grid = 0;
    if (grid == 0) {
        if (n_in != 31 || in_sizes[0] != NLAT * DM || out_size != NLAT * DM || ws_size < WS_END) { fprintf(stderr, "kernel_launch: unexpected shapes (n_in %d, in0 %d, out %d, ws %zu < %zu); nothing launched\n", n_in, n_in > 0 ? in_sizes[0] : -1, out_size, ws_size, (size_t)WS_END); grid = -1; return; }
        int dev = 0, cus = 0, per_cu = 0;
        if (hipGetDevice(&dev) != hipSuccess || hipDeviceGetAttribute(&cus, hipDeviceAttributeMultiprocessorCount, dev) != hipSuccess) { grid = -1; return; }
        if (hipFuncSetAttribute((const void*)mk_fwd, hipFuncAttributeMaxDynamicSharedMemorySize, LDS_BYTES) != hipSuccess) { fprintf(stderr, "kernel_launch: hipFuncSetAttribute failed\n"); grid = -1; return; }
        if (hipOccupancyMaxActiveBlocksPerMultiprocessor(&per_cu, (const void*)mk_fwd, NTHR, LDS_BYTES) != hipSuccess || per_cu < 1) { fprintf(stderr, "kernel_launch: occupancy query says %d blocks per CU\n", per_cu); (void)hipGetLastError(); grid = -1; return; }
        grid = cus;
    }
    if (grid < 0) return;
    if (hipMemsetAsync((char*)d_ws + WS_CTL, 0, CTL_ZERO_BYTES, stream) != hipSuccess) return;
    Args a{};
    for (int i = 0; i < 31; ++i) a.in[i] = (const float*)d_in[i];
    a.out = (float*)d_out; a.ws = (unsigned char*)d_ws;
#if MK_PER_PHASE
    for (int p = 0; p < N_PHASES; ++p) { a.ph_lo = p; a.ph_hi = p + 1; hipLaunchKernelGGL(mk_fwd, dim3(grid), dim3(NTHR), LDS_BYTES, stream, a); }
#else
    a.ph_lo = 0; a.ph_hi = N_PHASES;
    void* kargs[] = {&a};
    hipError_t e = hipLaunchCooperativeKernel((const void*)mk_fwd, dim3(grid), dim3(NTHR), kargs, LDS_BYTES, stream);
    if (e != hipSuccess) fprintf(stderr, "kernel_launch: cooperative launch failed: %s (grid %d)\n", hipGetErrorString(e), grid);
#endif
}
```

```cpp
#include <hip/hip_runtime.h>
#include <hip/hip_bf16.h>
#include <cstdio>
#include <cstdint>

#ifndef MK_PER_PHASE
#define MK_PER_PHASE 0
#endif

#ifndef PROBE_A
#define PROBE_A -1
#endif
#ifndef PROBE_B
#define PROBE_B -1
#endif
#ifndef PROBE_AE
#define PROBE_AE (PROBE_A + 1)
#endif
#ifndef PROBE_BE
#define PROBE_BE (PROBE_B + 1)
#endif
#ifndef PROBE_FS
#define PROBE_FS 500
#endif
#ifndef PROBE_FSB
#define PROBE_FSB PROBE_FS
#endif
#ifndef PROBE_ATTV
#define PROBE_ATTV -1
#endif
#ifndef PROBE_CVT
#define PROBE_CVT -1
#endif
#ifndef PROBE_SSDV
#define PROBE_SSDV -1
#endif
#define PROBING (PROBE_A >= 0 || PROBE_B >= 0)

#define LAS __attribute__((address_space(3)))
typedef unsigned short bf16;
typedef short bf16x8 __attribute__((ext_vector_type(8)));
typedef float f32x4 __attribute__((ext_vector_type(4)));
typedef float f32x2 __attribute__((ext_vector_type(2)));
typedef float f32x16 __attribute__((ext_vector_type(16)));
typedef unsigned u32x4 __attribute__((ext_vector_type(4)));
typedef unsigned u32x2 __attribute__((ext_vector_type(2)));
typedef __bf16 bf16x2_t __attribute__((ext_vector_type(2)));

constexpr int DM = 1024, NB = 8, SEQ = 2048, CTXL = 256, NLAT = NB * SEQ, NCTX = NB * CTXL, NTOK = NLAT + NCTX;
constexpr int DFF = 2816, NMOD = 9, MODW = NMOD * DM, DIN = 6064;
constexpr float EPS = 1e-6f;
constexpr float QSCALE = 0.10206207261596577f * 1.4426950408889634f;
constexpr int NWAVES = 8, NTHR = 512;

__device__ __forceinline__ unsigned pk2(float lo, float hi) { f32x2 v = {lo, hi}; bf16x2_t b = __builtin_convertvector(v, bf16x2_t); return __builtin_bit_cast(unsigned, b); }
__device__ __forceinline__ bf16 f2bf(float f) { return (bf16)(pk2(f, 0.f) & 0xffffu); }
__device__ __forceinline__ float bf2f(bf16 b) { return __uint_as_float((unsigned)b << 16); }
__device__ __forceinline__ float bflo(unsigned w) { return __uint_as_float(w << 16); }
__device__ __forceinline__ float bfhi(unsigned w) { return __uint_as_float(w & 0xffff0000u); }
__device__ __forceinline__ u32x4 pack8(f32x4 a, f32x4 b) { u32x4 w; w.x = pk2(a[0], a[1]); w.y = pk2(a[2], a[3]); w.z = pk2(b[0], b[1]); w.w = pk2(b[2], b[3]); return w; }
__device__ __forceinline__ void unpack8(u32x4 w, float* f) { f[0] = bflo(w.x); f[1] = bfhi(w.x); f[2] = bflo(w.y); f[3] = bfhi(w.y); f[4] = bflo(w.z); f[5] = bfhi(w.z); f[6] = bflo(w.w); f[7] = bfhi(w.w); }
__device__ __forceinline__ float rcpf_(float x) { return __builtin_amdgcn_rcpf(x); }
__device__ __forceinline__ float rsqf_(float x) { return __builtin_amdgcn_rsqf(x); }
__device__ __forceinline__ float sigmoidf_(float x) { return rcpf_(1.0f + __expf(-x)); }
__device__ __forceinline__ float siluf_(float x) { return x * rcpf_(1.0f + __expf(-x)); }
__device__ __forceinline__ float gelu_tanh(float x) { const float y = 1.5957691216057308f * (x + 0.044715f * x * x * x); return x * rcpf_(1.0f + __expf(-y)); }
__device__ __forceinline__ f32x4 rcp1p_exp2_4(f32x4 t) { f32x4 e;
#pragma unroll
    for (int j = 0; j < 4; ++j) e[j] = __builtin_amdgcn_exp2f(t[j]);
    e = e + 1.0f;
#pragma unroll
    for (int j = 0; j < 4; ++j) e[j] = rcpf_(e[j]);
    return e; }
__device__ __forceinline__ f32x4 silu4(f32x4 x) { return x * rcp1p_exp2_4(x * -1.4426950408889634f); }
__device__ __forceinline__ f32x4 gelu_tanh4(f32x4 x) { const f32x4 t = x * x * 0.044715f + 1.0f; return x * rcp1p_exp2_4(x * t * (-1.5957691216057308f * 1.4426950408889634f)); }
__device__ __forceinline__ float softplusf_(float x) {
    const float e = __expf(-fabsf(x)); const float l = e < 0.01f ? e * (1.0f - e * (0.5f - e * (1.0f / 3.0f))) : __logf(1.0f + e); return fmaxf(x, 0.f) + l; }
__device__ __forceinline__ float wave_sum(float v) {
#pragma unroll
    for (int o = 1; o < 64; o <<= 1) v += __shfl_xor(v, o);
    return v;
}
__device__ __forceinline__ float sum_fq(float x) {
    auto a = __builtin_amdgcn_permlane16_swap(__float_as_uint(x), __float_as_uint(x), false, false); x = __uint_as_float(a[0]) + __uint_as_float(a[1]);
    auto b = __builtin_amdgcn_permlane32_swap(__float_as_uint(x), __float_as_uint(x), false, false); return __uint_as_float(b[0]) + __uint_as_float(b[1]); }
__device__ __forceinline__ float max_x32(float x) { auto b = __builtin_amdgcn_permlane32_swap(__float_as_uint(x), __float_as_uint(x), false, false); return fmaxf(__uint_as_float(b[0]), __uint_as_float(b[1])); }
__device__ __forceinline__ float sum_x32(float x) { auto b = __builtin_amdgcn_permlane32_swap(__float_as_uint(x), __float_as_uint(x), false, false); return __uint_as_float(b[0]) + __uint_as_float(b[1]); }
__device__ __forceinline__ int mod_row(int row) { return row < NLAT ? (row >> 11) : 8; }

namespace pg8 {
#define PG8_LAS __attribute__((address_space(3)))
typedef unsigned short bf16_t;
constexpr int BM = 256, BK = 64, HALF = 128, HTB = HALF * BK * 2, STAGE_BYTES = 8 * HTB, NXCD = 8, WGM = 4;
__host__ __device__ __forceinline__ int lds_byte(int r, int c) { const int st = (r >> 4) * 2 + (c >> 5), rr = r & 15, cc = c & 31, ob = rr * 64 + cc * 2; return st * 1024 + (ob ^ (((ob >> 9) & 1) << 5)); }
__host__ __device__ __forceinline__ void stage_rc(int b, int& R, int& C) { const int st = b / 1024, sb = b % 1024, swz = sb ^ (((sb >> 9) & 1) << 5); R = (st >> 1) * 16 + swz / 64; C = (st & 1) * 32 + (swz % 64) / 2; }
__host__ __device__ __forceinline__ int perm32(int rho) { const int n = rho >> 4, i = rho & 15; return 8 * (i >> 2) + 4 * n + (i & 3); }

struct Unit { int pm, pn, ks; };
struct Gemm { const bf16_t* A; const bf16_t* Bt; int M, N, K, lda, ldb; const bf16_t* A1; const bf16_t* A2; const bf16_t* B1; const bf16_t* B2; };

struct StaticOrder {
    static constexpr bool CHAIN = false; static constexpr bool BRANCH = false;
    int nM, nN, nwg, G, c;
    __host__ __device__ void init(int M, int N, int G_, int c_) { nM = M / BM; nN = N / BM; nwg = nM * nN; G = G_; c = c_; }
    __host__ __device__ bool next(int i, Unit& u) const {
        const long L = (long)i * G + c; if (L >= nwg) return false;
        int wgid = (int)L; { const int q = nwg / NXCD, r = nwg % NXCD, xcd = wgid % NXCD, off = wgid / NXCD; wgid = (xcd < r ? xcd * (q + 1) : r * (q + 1) + (xcd - r) * q) + off; }
        const int nig = WGM * nN, gid = wgid / nig, fm = gid * WGM, gsz = (nM - fm) < WGM ? (nM - fm) : WGM;
        u.pm = fm + ((wgid % nig) % gsz); u.pn = (wgid % nig) / gsz; u.ks = 0; return true;
    }
    __device__ __forceinline__ void a_ready(const Unit&) const {}
    __device__ __forceinline__ void done(const Unit&) const {}
};
struct SliceOrder {
    static constexpr bool CHAIN = false; static constexpr bool BRANCH = false;
    int nM, nN, S, nwg, G, c;
    __host__ __device__ void init(int M, int N, int S_, int G_, int c_) { nM = M / BM; nN = N / BM; S = S_; nwg = nM * nN * S; G = G_; c = c_; }
    __host__ __device__ bool next(int i, Unit& u) const {
        const long L = (long)i * G + c; if (L >= nwg) return false;
        const int s = (int)L % S, t = (int)L / S; u.pn = t % nN; u.pm = t / nN; u.ks = s; return true;
    }
    __device__ __forceinline__ void a_ready(const Unit&) const {}
    __device__ __forceinline__ void done(const Unit&) const {}
};

struct BranchOrder {
    static constexpr bool CHAIN = false; static constexpr bool BRANCH = true;
    int nM, nN, nwg, G, c;
    __host__ __device__ void init(int M, int N, int G_, int c_) { nM = M / BM; nN = N / BM; nwg = nM * nN * 3; G = G_; c = c_; }
    __host__ __device__ bool next(int i, Unit& u) const {
        const long L = (long)i * G + c; if (L >= nwg) return false;
        const int t = (int)L / 3; u.ks = (int)L % 3; u.pn = t % nN; u.pm = t / nN; return true;
    }
    __device__ __forceinline__ void a_ready(const Unit&) const {}
    __device__ __forceinline__ void done(const Unit&) const {}
};
struct ChainOrder {
    static constexpr bool CHAIN = true; static constexpr bool BRANCH = false;
    int nM, nN, nt, G, c;
    __host__ __device__ void init(int M, int N, int G_, int c_) { nM = M / BM; nN = N / BM; nt = nM * nN; G = G_; c = c_; }
    __host__ __device__ bool next(int i, Unit& u) const {
        const int seg = i % 3; const long t = (long)(i / 3) * G + c; if (t >= nt) return false;
        u.pn = (int)t % nN; u.pm = (int)t / nN; u.ks = seg; return true;
    }
    __device__ __forceinline__ void a_ready(const Unit&) const {}
    __device__ __forceinline__ void done(const Unit&) const {}
};
template <class F> struct Epi8 {
    static constexpr bool PERM = true, AFTER_DRAIN = false; F f;
    __device__ __forceinline__ void operator()(const f32x4 (&acc)[2][2][4][2], const Unit& u, int wr, int wc, int fr, int fq) const {
        asm volatile("" : "+v"(fr), "+v"(fq));
#pragma unroll
        for (int ai = 0; ai < 2; ++ai)
#pragma unroll
            for (int m = 0; m < 4; ++m) { const int row = u.pm * BM + ai * HALF + wr * 64 + m * 16 + fr;
#pragma unroll
                for (int bj = 0; bj < 2; ++bj) f(row, u.pn * BM + bj * HALF + wc * 32 + 8 * fq, acc[ai][bj][m][0], acc[ai][bj][m][1]); }
    }
};
template <class F> struct Epi4 {
    static constexpr bool PERM = false, AFTER_DRAIN = false; F f;
    __device__ __forceinline__ void operator()(const f32x4 (&acc)[2][2][4][2], const Unit& u, int wr, int wc, int fr, int fq) const {
        asm volatile("" : "+v"(fr), "+v"(fq));
#pragma unroll
        for (int ai = 0; ai < 2; ++ai)
#pragma unroll
            for (int m = 0; m < 4; ++m) { const int row = u.pm * BM + ai * HALF + wr * 64 + m * 16 + fr;
#pragma unroll
                for (int bj = 0; bj < 2; ++bj)
#pragma unroll
                    for (int n = 0; n < 2; ++n) f(row, u.pn * BM + bj * HALF + wc * 32 + n * 16 + 4 * fq, acc[ai][bj][m][n]); }
    }
};
template <class F> struct EpiGU {
    static constexpr bool PERM = true, AFTER_DRAIN = false; F f;
    __device__ __forceinline__ void operator()(const f32x4 (&acc)[2][2][4][2], const Unit& u, int wr, int wc, int fr, int fq) const {
        asm volatile("" : "+v"(fr), "+v"(fq));
#pragma unroll
        for (int ai = 0; ai < 2; ++ai)
#pragma unroll
            for (int m = 0; m < 4; ++m) { const int row = u.pm * BM + ai * HALF + wr * 64 + m * 16 + fr;
                f(row, u.pn * HALF + wc * 32 + 8 * fq, acc[ai][0][m][0], acc[ai][0][m][1], acc[ai][1][m][0], acc[ai][1][m][1]); }
    }
};

template <class Epi, class Sched, bool ALIGN_EPI = false, bool SP2 = false>
__device__ __forceinline__ void gemm_phase(PG8_LAS unsigned char* lds, const Gemm g, const Sched& S, const Epi& E, int tid) {
    asm volatile("" : "+v"(tid));
    const int wid = __builtin_amdgcn_readfirstlane(tid >> 6), lane = tid & 63, wr = wid >> 2, wc = wid & 3, fr = lane & 15, fq = lane >> 4;
    const int K = g.K, nt = K / BK;
    unsigned voffA[2], voffB[2];
#pragma unroll
    for (int i = 0; i < 2; ++i) { int R, C; stage_rc(tid * 16 + i * 8192, R, C); const int Rb = Epi::PERM ? ((R & ~31) + perm32(R & 31)) : R;
        voffA[i] = (unsigned)(R * g.lda + C) * 2u; voffB[i] = (unsigned)(Rb * g.ldb + C) * 2u; }
    const size_t kstep = (size_t)(BK * 2);
    const size_t hstepA = (size_t)HALF * g.lda * 2, hstepB = (size_t)HALF * g.ldb * 2;
    const size_t tstepA = 2 * hstepA, tstepB = 2 * hstepB;
    const unsigned ldsw = (unsigned)wid * 1024u;
    const int aoff = lds_byte(wr * 64 + fr, fq * 8), boff = lds_byte(wc * 32 + fr, fq * 8);
#define PG8_SA(b, h) (((b) * 2 + (h)) * HTB)
#define PG8_SB(b, h) ((4 + (b) * 2 + (h)) * HTB)
#define PG8_STAGE(bufoff, gbase, voff) do { _Pragma("unroll") for (int _i = 0; _i < 2; ++_i) \
        __builtin_amdgcn_global_load_lds((const unsigned*)((const char*)(gbase) + (voff)[_i]), (PG8_LAS unsigned*)(lds + (bufoff) + ldsw + _i * 8192), 16, 0, 0); } while (0)
#define PG8_LDA(dst, b, h) do { _Pragma("unroll") for (int m = 0; m < 4; ++m) _Pragma("unroll") for (int k = 0; k < 2; ++k) dst[m][k] = *(const PG8_LAS bf16x8*)(lds + PG8_SA(b, h) + aoff + m * 2048 + k * 1024); } while (0)
#define PG8_LDB(dst, b, h) do { _Pragma("unroll") for (int n = 0; n < 2; ++n) _Pragma("unroll") for (int k = 0; k < 2; ++k) dst[n][k] = *(const PG8_LAS bf16x8*)(lds + PG8_SB(b, h) + boff + n * 2048 + k * 1024); } while (0)
#define PG8_MMA(ai, bj, At, Bt) do { __builtin_amdgcn_s_setprio(1); _Pragma("unroll") for (int m = 0; m < 4; ++m) _Pragma("unroll") for (int n = 0; n < 2; ++n) _Pragma("unroll") for (int k = 0; k < 2; ++k) \
        acc[ai][bj][m][n] = __builtin_amdgcn_mfma_f32_16x16x32_bf16(Bt[n][k], At[m][k], acc[ai][bj][m][n], 0, 0, 0); __builtin_amdgcn_s_setprio(0); } while (0)
#define PG8_WAIT_V(n) asm volatile("s_waitcnt vmcnt(" #n ")" ::: "memory")
#define PG8_WAIT_L(n) asm volatile("s_waitcnt lgkmcnt(" #n ")" ::: "memory")
#define PG8_BAR __builtin_amdgcn_s_barrier()
#define PG8_SCHED __builtin_amdgcn_sched_barrier(0)
    Unit cur, nxt; int ui = 0;
    if (!S.next(0, cur)) return;
    f32x4 acc[2][2][4][2];
#pragma unroll
    for (int a = 0; a < 2; ++a)
#pragma unroll
        for (int b = 0; b < 2; ++b)
#pragma unroll
            for (int m = 0; m < 4; ++m)
#pragma unroll
                for (int n = 0; n < 2; ++n) acc[a][b][m][n] = (f32x4){0.f, 0.f, 0.f, 0.f};
    bf16x8 At[4][2], B0[2][2], B1[2][2];
    const size_t sstep = (size_t)g.K * 2;
#define PG8_UA(u_) ((Sched::CHAIN || Sched::BRANCH) ? (const char*)((u_).ks == 0 ? g.A : ((u_).ks == 1 ? g.A1 : g.A2)) + (size_t)(u_).pm * tstepA : (const char*)g.A + (size_t)(u_).pm * tstepA + (size_t)(u_).ks * sstep)
#define PG8_UB(u_) ((Sched::CHAIN || Sched::BRANCH) ? (const char*)((u_).ks == 0 ? g.Bt : ((u_).ks == 1 ? g.B1 : g.B2)) + (size_t)(u_).pn * tstepB : (const char*)g.Bt + (size_t)(u_).pn * tstepB + (size_t)(u_).ks * sstep)
    const char* cA = PG8_UA(cur); const char* cB = PG8_UB(cur);
    S.a_ready(cur);
    if constexpr (SP2) {
        PG8_STAGE(PG8_SB(0, 0), cB, voffB); PG8_STAGE(PG8_SB(0, 1), cB + hstepB, voffB); PG8_STAGE(PG8_SA(0, 0), cA, voffA); PG8_STAGE(PG8_SA(0, 1), cA + hstepA, voffA);
        if (wr == 1) PG8_BAR;
        PG8_WAIT_V(2); PG8_BAR;
        PG8_STAGE(PG8_SB(1, 0), cB + kstep, voffB); PG8_STAGE(PG8_SA(1, 0), cA + kstep, voffA); PG8_STAGE(PG8_SB(1, 1), cB + hstepB + kstep, voffB);
        PG8_WAIT_V(6); PG8_BAR;
    } else {
        PG8_STAGE(PG8_SB(0, 0), cB, voffB); PG8_STAGE(PG8_SA(0, 0), cA, voffA); PG8_STAGE(PG8_SB(0, 1), cB + hstepB, voffB); PG8_STAGE(PG8_SA(0, 1), cA + hstepA, voffA);
        if (wr == 1) PG8_BAR;
        PG8_WAIT_V(4); PG8_BAR;
        PG8_STAGE(PG8_SB(1, 0), cB + kstep, voffB); PG8_STAGE(PG8_SA(1, 0), cA + kstep, voffA); PG8_STAGE(PG8_SB(1, 1), cB + hstepB + kstep, voffB);
        PG8_WAIT_V(6); PG8_BAR;
    }
    for (;;) {
        const bool has_next = S.next(ui + 1, nxt);
        const char* nA = has_next ? PG8_UA(nxt) : cA; const char* nB = has_next ? PG8_UB(nxt) : cB;
#pragma clang loop unroll(disable)
        for (int t = 0; t < nt; t += 2) {
            const bool last = (t == nt - 2);
            const char* a1 = cA + (size_t)(t + 1) * kstep;
            const char* a2 = last ? nA : cA + (size_t)(t + 2) * kstep; const char* b2 = last ? nB : cB + (size_t)(t + 2) * kstep;
            const char* a3 = a2 + kstep; const char* b3 = b2 + kstep;
            if (last && has_next) S.a_ready(nxt);
            if constexpr (SP2) {
            PG8_LDB(B0, 0, 0); PG8_LDB(B1, 0, 1); PG8_SCHED; PG8_LDA(At, 0, 0); PG8_STAGE(PG8_SA(1, 1), a1 + hstepA, voffA);
            PG8_WAIT_V(8); PG8_WAIT_L(0); PG8_BAR; PG8_MMA(0, 0, At, B0); PG8_MMA(0, 1, At, B1); PG8_BAR; PG8_SCHED;
            PG8_LDA(At, 0, 1); PG8_STAGE(PG8_SB(0, 0), b2, voffB); PG8_STAGE(PG8_SB(0, 1), b2 + hstepB, voffB); PG8_STAGE(PG8_SA(0, 0), a2, voffA);
            PG8_WAIT_V(8); PG8_WAIT_L(0); PG8_BAR; PG8_MMA(1, 0, At, B0); PG8_MMA(1, 1, At, B1); PG8_BAR; PG8_SCHED;
            PG8_LDB(B0, 1, 0); PG8_LDB(B1, 1, 1); PG8_SCHED; PG8_LDA(At, 1, 0); PG8_STAGE(PG8_SA(0, 1), a2 + hstepA, voffA);
            PG8_WAIT_V(8); PG8_WAIT_L(0); PG8_BAR; PG8_MMA(0, 0, At, B0); PG8_MMA(0, 1, At, B1); PG8_BAR; PG8_SCHED;
            PG8_LDA(At, 1, 1); PG8_STAGE(PG8_SB(1, 0), b3, voffB); PG8_STAGE(PG8_SB(1, 1), b3 + hstepB, voffB); PG8_STAGE(PG8_SA(1, 0), a3, voffA);
            PG8_WAIT_V(8); PG8_WAIT_L(0); PG8_BAR; PG8_MMA(1, 0, At, B0); PG8_MMA(1, 1, At, B1); PG8_BAR; PG8_SCHED;
            } else {
            PG8_LDB(B0, 0, 0); PG8_SCHED; PG8_LDA(At, 0, 0); PG8_STAGE(PG8_SA(1, 1), a1 + hstepA, voffA);
            PG8_WAIT_L(8); PG8_BAR; PG8_WAIT_L(0); PG8_MMA(0, 0, At, B0); PG8_BAR; PG8_SCHED;
            PG8_LDB(B1, 0, 1); PG8_STAGE(PG8_SB(0, 0), b2, voffB);
            PG8_BAR; PG8_WAIT_L(0); PG8_MMA(0, 1, At, B1); PG8_BAR;
            PG8_LDA(At, 0, 1); PG8_STAGE(PG8_SA(0, 0), a2, voffA);
            PG8_BAR; PG8_WAIT_L(0); PG8_MMA(1, 0, At, B0); PG8_BAR; PG8_SCHED;
            PG8_STAGE(PG8_SB(0, 1), b2 + hstepB, voffB);
            PG8_WAIT_V(6); PG8_BAR; PG8_MMA(1, 1, At, B1); PG8_BAR;
            PG8_LDB(B0, 1, 0); PG8_SCHED; PG8_LDA(At, 1, 0); PG8_STAGE(PG8_SA(0, 1), a2 + hstepA, voffA);
            PG8_WAIT_L(8); PG8_BAR; PG8_WAIT_L(0); PG8_MMA(0, 0, At, B0); PG8_BAR; PG8_SCHED;
            PG8_LDB(B1, 1, 1); PG8_STAGE(PG8_SB(1, 0), b3, voffB);
            PG8_BAR; PG8_WAIT_L(0); PG8_MMA(0, 1, At, B1); PG8_BAR;
            PG8_LDA(At, 1, 1); PG8_STAGE(PG8_SA(1, 0), a3, voffA);
            PG8_BAR; PG8_WAIT_L(0); PG8_MMA(1, 0, At, B0); PG8_BAR; PG8_SCHED;
            PG8_STAGE(PG8_SB(1, 1), b3 + hstepB, voffB);
            PG8_WAIT_V(6); PG8_BAR; PG8_MMA(1, 1, At, B1); PG8_BAR;
            }
        }
        if constexpr (ALIGN_EPI) { if (wr == 0) PG8_BAR; }
        bool zero_acc = true;
        if constexpr (Sched::CHAIN) { E.chain(acc, cur, wr, wc, fr, fq); zero_acc = (cur.ks == 2); }
        else if constexpr (!Epi::AFTER_DRAIN) { E(acc, cur, wr, wc, fr, fq); S.done(cur); }
        if (!has_next) break;
        if (zero_acc) {
#pragma unroll
        for (int a = 0; a < 2; ++a)
#pragma unroll
            for (int b = 0; b < 2; ++b)
#pragma unroll
                for (int m = 0; m < 4; ++m)
#pragma unroll
                    for (int n = 0; n < 2; ++n) acc[a][b][m][n] = (f32x4){0.f, 0.f, 0.f, 0.f};
        }
        cur = nxt; cA = nA; cB = nB; ++ui;
        if constexpr (ALIGN_EPI) { if (wr == 1) PG8_BAR; }
    }
    PG8_WAIT_V(0);
    if constexpr (!ALIGN_EPI) { if (wr == 0) PG8_BAR; }
    PG8_BAR;
#undef PG8_UA
#undef PG8_UB
#undef PG8_SA
#undef PG8_SB
#undef PG8_STAGE
#undef PG8_LDA
#undef PG8_LDB
#undef PG8_MMA
#undef PG8_WAIT_V
#undef PG8_WAIT_L
#undef PG8_BAR
#undef PG8_SCHED
}
}

constexpr size_t MiB = 1u << 20;
constexpr size_t WS_CTL = 0, CTL_ZERO_BYTES = 1 * MiB;
constexpr size_t WS_MOD = 1 * MiB;
constexpr size_t WS_ROPE = 2 * MiB;
constexpr size_t WS_STAT = 3 * MiB;
constexpr size_t WS_RSSN = WS_STAT + 4 * (size_t)18432 * 4;
constexpr size_t WS_W = 4 * MiB;
constexpr size_t WS_XCTX = 56 * MiB;
constexpr size_t WS_H = 64 * MiB;
constexpr size_t WS_BIG = 100 * MiB;
constexpr size_t B_KVR = WS_BIG + 0 * MiB, B_QLAT = WS_BIG + 9 * MiB, B_AMLA = WS_BIG + 0 * MiB;
constexpr size_t B_XBCR = WS_BIG + 18 * MiB, B_YF = WS_BIG + 18 * MiB, B_YB = WS_BIG + 36 * MiB;
constexpr size_t B_UV = WS_BIG + 54 * MiB, B_SZ = WS_BIG + 90 * MiB;
constexpr size_t B_Q = WS_BIG + 108 * MiB, B_KN = WS_BIG + 135 * MiB, B_KRP = WS_BIG + 153 * MiB, B_V = WS_BIG + 155 * MiB, B_XBC = WS_BIG + 173 * MiB, B_DT = WS_BIG + 209 * MiB;
constexpr size_t B_GATES = WS_BIG + 108 * MiB, B_ACT = WS_BIG + 0 * MiB;
constexpr size_t B_SLAB = WS_BIG + 100 * MiB;
constexpr size_t B_H2 = WS_BIG + 140 * MiB;
constexpr size_t WS_SHW = WS_BIG + 216 * MiB;
constexpr size_t SHW_F1 = 0, SHW_INA = 8 * 5632, SHW_GATE = SHW_INA + 8 * 3072, SHW_F2 = SHW_GATE + 8 * 3072, SHW_LAYER = SHW_F2 + 8 * 5632;
constexpr size_t B_MSLAB = WS_BIG + 54 * MiB;
constexpr size_t B_GM = WS_BIG + 218 * MiB;
constexpr size_t B_XF = WS_BIG + 100 * MiB;
constexpr size_t WS_END = WS_BIG + 236 * MiB;
constexpr size_t W_F1I = 0, W_F1O = W_F1I + (size_t)5632 * 1024, W_F2I = W_F1O + (size_t)1024 * 2816, W_F2O = W_F2I + (size_t)5632 * 1024;
constexpr size_t W_INA = W_F2O + (size_t)1024 * 2816, W_GATE = W_INA + (size_t)3072 * 1024, W_UQ = W_GATE + (size_t)3072 * 1024, W_UKV = W_UQ + (size_t)768 * 256;
constexpr size_t W_MO = W_UKV + (size_t)1024 * 256, W_SO = W_MO + (size_t)1024 * 512, W_GO = W_SO + (size_t)1024 * 512, W_OUT = W_GO + (size_t)1024 * 512, W_GS = W_OUT + (size_t)1024 * 1024, W_ENDW = W_GS + (size_t)8 * 128 * 128;
static_assert(W_ENDW * 2 <= 52 * MiB, "weights fit");
constexpr int CW_BAR = 4096;
constexpr int CW_QUEUE = 16384;
constexpr int CW_TS = 32768;

constexpr int LDS_PHASE_BYTES = 147456;
constexpr int MISC_OFF = LDS_PHASE_BYTES;
constexpr int LDS_BYTES = LDS_PHASE_BYTES + 256;

#define XB_TMO      128
#define XB_XCNT(j)  (256  + 64 * (j))
#define XB_XSUB(j)  (1280 + 64 * (j))
#define XB_XGEN(j)  (2304 + 64 * (j))
#define XB_TOP      3328
#define XB_TOPGEN   3392
#define XCD_BAR_WORDS 3456
#define XB_SPIN_CAP (1u << 22)
__device__ __forceinline__ unsigned xb_ld(unsigned* p)              { return __hip_atomic_load(p, __ATOMIC_RELAXED, __HIP_MEMORY_SCOPE_AGENT); }
__device__ __forceinline__ unsigned xb_add(unsigned* p, unsigned v) { return __hip_atomic_fetch_add(p, v, __ATOMIC_RELAXED, __HIP_MEMORY_SCOPE_AGENT); }
__device__ __forceinline__ unsigned xb_xcc_id() { return (unsigned)__builtin_amdgcn_s_getreg((3 << 11) | 20) & 0xFu; }
#define XB_SPIN(cond, bar) do { unsigned _sp = 0; while (cond) { __builtin_amdgcn_s_sleep(1); \
    if ((++_sp & 255u) == 0u) { if (xb_ld(&(bar)[XB_TMO])) break; if (_sp > XB_SPIN_CAP) { atomicAdd(&(bar)[XB_TMO], 1u); break; } } } } while (0)
struct XcdBarrier { unsigned* bar; unsigned x; volatile LAS unsigned* st; };
__device__ __forceinline__ XcdBarrier xcd_barrier_post(unsigned* bar, volatile LAS unsigned* st) {
    XcdBarrier b; b.bar = bar; b.x = xb_xcc_id(); b.st = st;
    if (threadIdx.x == 0) (void)xb_add(&bar[XB_XCNT(b.x)], 1u);
    return b;
}
__device__ __forceinline__ void xcd_barrier_complete(unsigned* bar, unsigned x, unsigned& nloc, unsigned& nx) {
    const unsigned G = gridDim.x * gridDim.y * gridDim.z;
    unsigned sum, cnt, mine, sp = 0u;
    for (;;) {
        sum = 0u; cnt = 0u; mine = 0u;
#pragma unroll
        for (unsigned j = 0; j < 16; ++j) { const unsigned c = xb_ld(&bar[XB_XCNT(j)]); sum += c; cnt += (c > 0u) ? 1u : 0u; mine = (j == x) ? c : mine; }
        if (sum == G) break;
        __builtin_amdgcn_s_sleep(1);
        if ((++sp & 255u) == 0u) { if (xb_ld(&bar[XB_TMO])) break; if (sp > XB_SPIN_CAP) { atomicAdd(&bar[XB_TMO], 1u); break; } }
    }
    nloc = mine > 0u ? mine : 1u; nx = cnt > 0u ? cnt : 1u;
}
__device__ __forceinline__ void xcd_barrier(const XcdBarrier& b, int wave) {
    asm volatile("s_waitcnt vmcnt(0)" ::: "memory");
    __syncthreads();
    if (wave == 0 && __builtin_amdgcn_mbcnt_hi(~0u, __builtin_amdgcn_mbcnt_lo(~0u, 0u)) == 0u) {
        unsigned* bar = b.bar;
        __builtin_amdgcn_s_waitcnt(0);
        unsigned nloc = b.st[0], nx = b.st[1];
        if (nloc == 0u) { xcd_barrier_complete(bar, b.x, nloc, nx); b.st[0] = nloc; b.st[1] = nx; }
        const unsigned old = xb_add(&bar[XB_XSUB(b.x)], 1u);
        const unsigned gen = old / nloc;
        if (old + 1u == (gen + 1u) * nloc) {
            __builtin_amdgcn_fence(__ATOMIC_RELEASE, "agent");
            asm volatile("s_waitcnt vmcnt(0)" ::: "memory");
            const unsigned og = xb_add(&bar[XB_TOP], 1u);
            const unsigned tg = og / nx;
            if (og + 1u == (tg + 1u) * nx) xb_add(&bar[XB_TOPGEN], 1u);
            else XB_SPIN(xb_ld(&bar[XB_TOPGEN]) == tg, bar);
            __builtin_amdgcn_fence(__ATOMIC_ACQUIRE, "agent");
            xb_add(&bar[XB_XGEN(b.x)], 1u);
            asm volatile("s_waitcnt vmcnt(0)" ::: "memory");
        } else {
            XB_SPIN(xb_ld(&bar[XB_XGEN(b.x)]) == gen, bar);
            __builtin_amdgcn_fence(__ATOMIC_ACQUIRE, "agent");
            asm volatile("s_waitcnt vmcnt(0)" ::: "memory");
        }
    }
    __syncthreads();
}

struct Args { const float* in[31]; float* out; unsigned char* ws; int ph_lo, ph_hi; };
static_assert(sizeof(Args) == 272, "kernarg layout");
enum { I_X = 0, I_C, I_CTX, I_CCTX, I_WADA, I_BADA, I_NORMG, I_F1WI, I_F1WO, I_F2WI, I_F2WO, I_WIN, I_QNORM, I_WUQ, I_KVNORM, I_WUKV, I_WMO,
       I_CONVW, I_CONVB, I_ALOG, I_DTBIAS, I_SSMD, I_SSMNORM, I_WSO, I_GMNORM, I_GMWS, I_GMBS, I_GMWO, I_BGATE, I_WOUT, I_FNORM };

struct Frame {
    LAS unsigned char* lds;
    int tid, lane, wave, G, vcu, bid;
    size_t z;
    const __attribute__((address_space(4))) char* ka;
};
#define GAS __attribute__((address_space(1)))
#define KA_PTR(T, byteoff) ((T*)(*(GAS T* const __attribute__((address_space(4)))*)(F.ka + (byteoff))))
#define WS_BASE (KA_PTR(unsigned char, 256) + F.z)
#define WSP(T, off) ((T*)(WS_BASE + (off)))
#define INP(k) (KA_PTR(const float, 8 * (k)) + F.z)
#define OUTP (KA_PTR(float, 248) + F.z)
#define F2ALT ((bf16*)OUTP + (size_t)NLAT * DM)
#define XBP ((bf16*)OUTP)
#define WGT(off) (WSP(bf16, WS_W) + (off))

typedef _Float16 h16x2_t __attribute__((ext_vector_type(2)));
typedef _Float16 h16x4_t __attribute__((ext_vector_type(4)));
__device__ __forceinline__ u32x2 xs_pack(f32x4 v) {
#pragma unroll
    for (int j = 0; j < 4; ++j) v[j] = __builtin_amdgcn_fmed3f(v[j], -65504.f, 65504.f);
    const h16x4_t h = __builtin_convertvector(v, h16x4_t); return __builtin_bit_cast(u32x2, h); }
__device__ __forceinline__ f32x4 xs_unpack(u32x2 w) { const h16x4_t h = __builtin_bit_cast(h16x4_t, w); return __builtin_convertvector(h, f32x4); }
__device__ __forceinline__ const float* xrow_in(const Frame& F, int row, bool from_inputs) {
    if (from_inputs) return row < NLAT ? INP(I_X) + (size_t)row * DM : INP(I_CTX) + (size_t)(row - NLAT) * DM;
    return WSP(float, WS_XCTX) + (size_t)(row - NLAT) * DM;
}
__device__ __forceinline__ float* xrow_out(const Frame& F, int row) { return WSP(float, WS_XCTX) + (size_t)(row - NLAT) * DM; }

template <class Map> __device__ __forceinline__ void transpose_items(const Frame& F, int& base, int gw, int NGW, const float* W, int Ksrc, int Nsrc, bf16* WT, int Kdst, int Ndst, const float* kscale, Map map) {
    LAS float* scr = (LAS float*)(F.lds + F.wave * 16640);
    const int nblk = Ndst / 64, nitems = (Kdst / 64) * nblk;
    const int first = (gw - (base % NGW) + NGW) % NGW;
    const int lk = F.lane >> 4, ln = (F.lane & 15) * 4;
    for (int item = first; item < nitems; item += NGW) {
        const int kb = item / nblk, nb = item - kb * nblk, k0 = 64 * kb, n0 = 64 * nb;
        const int sc = map(n0 + ln); const int scol = sc < 0 ? 0 : sc;
        f32x4 v[16];
#pragma unroll
        for (int i = 0; i < 16; ++i) { const int k = k0 + lk + 4 * i, kc = k < Ksrc ? k : Ksrc - 1; v[i] = *(const f32x4*)(W + (size_t)kc * Nsrc + scol); }
#pragma unroll
        for (int i = 0; i < 16; ++i) { const int k = k0 + lk + 4 * i, kc = k < Ksrc ? k : Ksrc - 1; float m = (sc >= 0 && k < Ksrc) ? 1.f : 0.f; if (kscale) m *= kscale[kc];
            LAS float* d = scr + (lk + 4 * i) * 65 + ln; d[0] = v[i][0] * m; d[1] = v[i][1] * m; d[2] = v[i][2] * m; d[3] = v[i][3] * m; }
        asm volatile("s_waitcnt lgkmcnt(0)" ::: "memory");
        const int c = F.lane & 7;
#pragma unroll
        for (int j = 0; j < 8; ++j) { const int n = (F.lane >> 3) + 8 * j; const LAS float* p = scr + (8 * c) * 65 + n;
            u32x4 o; o.x = pk2(p[0 * 65], p[1 * 65]); o.y = pk2(p[2 * 65], p[3 * 65]); o.z = pk2(p[4 * 65], p[5 * 65]); o.w = pk2(p[6 * 65], p[7 * 65]);
            *(u32x4*)(WT + (size_t)(n0 + n) * Kdst + k0 + 8 * c) = o; }
        asm volatile("s_waitcnt lgkmcnt(0)" ::: "memory");
    }
    base += nitems;
}
struct MapId { __device__ __forceinline__ int operator()(int n) const { return n; } };
struct MapOff { int off; __device__ __forceinline__ int operator()(int n) const { return n + off; } };
struct MapFfnIn { __device__ __forceinline__ int operator()(int n) const { const int pn = n >> 8, j = n & 255; return j < 128 ? pn * 128 + j : DFF + pn * 128 + (j - 128); } };
__device__ __forceinline__ int rope_src(int w) { const int blk = w >> 3, half = (w >> 2) & 1, jj = w & 3, i = blk * 4 + jj; return half ? 16 + i : i; }
struct MapInA { __device__ __forceinline__ int operator()(int n) const {
    if (n < 128) return n;
    if (n < 160) return 128 + rope_src(n - 128);
    if (n < 176) return 1184 + (n - 160);
    if (n < 256) return -1;
    if (n < 1280) return 160 + (n - 256);
    if (n < 1536) return 1200 + (n - 1280);
    if (n < 2048) return 1456 + (n - 1536);
    return 1968 + (n - 2048);
} };
struct MapUq { __device__ __forceinline__ int operator()(int n) const {
    if (n < 512) return 96 * (n >> 6) + (n & 63);
    const int c = n - 512, h = c >> 5; return 96 * h + 64 + rope_src(c & 31);
} };

__device__ __forceinline__ void convert_set(const Frame& F, int l, int set, int idx, int nw, bf16* f2) {
    const int gw = idx * NWAVES + F.wave, NGW = nw * NWAVES; int base = 0;
    if (set == 0) {
        transpose_items(F, base, gw, NGW, INP(I_F2WI) + (size_t)l * DM * 2 * DFF, DM, 2 * DFF, f2, DM, 2 * DFF, nullptr, MapFfnIn{});
    } else if (set == 1) {
        transpose_items(F, base, gw, NGW, INP(I_F1WI) + (size_t)l * DM * 2 * DFF, DM, 2 * DFF, WGT(W_F1I), DM, 2 * DFF, nullptr, MapFfnIn{});
    } else if (set == 2) {
        transpose_items(F, base, gw, NGW, INP(I_F1WO) + (size_t)l * DFF * DM, DFF, DM, WGT(W_F1O), DFF, DM, nullptr, MapId{});
        transpose_items(F, base, gw, NGW, INP(I_WIN) + (size_t)l * DM * DIN, DM, DIN, WGT(W_INA), DM, 3072, nullptr, MapInA{});
    } else {
        transpose_items(F, base, gw, NGW, INP(I_F2WO) + (size_t)l * DFF * DM, DFF, DM, f2 + (W_F2O - W_F2I), DFF, DM, nullptr, MapId{});
        transpose_items(F, base, gw, NGW, INP(I_WIN) + (size_t)l * DM * DIN, DM, DIN, WGT(W_GATE), DM, 3072, nullptr, MapOff{2992});
        transpose_items(F, base, gw, NGW, INP(I_WUQ) + (size_t)l * 256 * 768, 256, 768, WGT(W_UQ), 256, 768, INP(I_QNORM) + l * 256, MapUq{});
        transpose_items(F, base, gw, NGW, INP(I_WUKV) + (size_t)l * 128 * 1024, 128, 1024, WGT(W_UKV), 256, 1024, INP(I_KVNORM) + l * 128, MapId{});
        transpose_items(F, base, gw, NGW, INP(I_WMO) + (size_t)l * 512 * 1024, 512, 1024, WGT(W_MO), 512, 1024, nullptr, MapId{});
        transpose_items(F, base, gw, NGW, INP(I_WSO) + (size_t)l * 512 * 1024, 512, 1024, WGT(W_SO), 512, 1024, nullptr, MapId{});
        transpose_items(F, base, gw, NGW, INP(I_GMWO) + (size_t)l * 512 * 1024, 512, 1024, WGT(W_GO), 512, 1024, nullptr, MapId{});
        transpose_items(F, base, gw, NGW, INP(I_WOUT) + (size_t)l * 1024 * 1024, 1024, 1024, WGT(W_OUT), 1024, 1024, nullptr, MapId{});
        const float* gs = INP(I_GMWS) + (size_t)l * 131072; bf16* gd = WGT(W_GS);
        for (int i = (idx * NTHR + F.tid) * 4; i < 131072; i += nw * NTHR * 4) { const f32x4 v = *(const f32x4*)(gs + i); u32x2 o; o.x = pk2(v[0], v[1]); o.y = pk2(v[2], v[3]); *(u32x2*)(gd + i) = o; }
    }
}
__device__ __forceinline__ void tail_convert(const Frame& F, int nwg, int set) {
    const int r = nwg % F.G; const bool sh = r > 0 && F.G - r >= 64;
    if (sh && F.bid < r) return;
    __syncthreads();
    convert_set(F, 1, set, sh ? F.bid - r : F.bid, sh ? F.G - r : F.G, F2ALT);
}

__device__ __forceinline__ void prologue_mod(const Frame& F) {
    LAS float* sc = (LAS float*)(F.lds);
    LAS float* red = (LAS float*)(F.lds + 36864);
    if (F.bid < 72) {
    for (int i = F.tid; i < 9 * 1024; i += NTHR) { const int r = i >> 10, k = i & 1023; const float v = r < 8 ? INP(I_C)[r * 1024 + k] : INP(I_CCTX)[k]; sc[i] = siluf_(v); }
    __syncthreads();
    for (int u = F.bid; u < 72; u += F.G) {
        const int l = u / 36, j0 = (u % 36) * 256 + F.lane * 4;
        const float* W = INP(I_WADA) + (size_t)l * DM * MODW + j0;
        f32x4 a[9];
#pragma unroll
        for (int r = 0; r < 9; ++r) a[r] = (f32x4){0.f, 0.f, 0.f, 0.f};
        const int kb = F.wave * 128;
        for (int k0 = kb; k0 < kb + 128; k0 += 8) { f32x4 w[8];
#pragma unroll
            for (int i = 0; i < 8; ++i) w[i] = *(const f32x4*)(W + (size_t)(k0 + i) * MODW);
#pragma unroll
            for (int i = 0; i < 8; ++i)
#pragma unroll
                for (int r = 0; r < 9; ++r) a[r] += w[i] * sc[r * 1024 + k0 + i]; }
#pragma unroll
        for (int r = 0; r < 9; ++r) *(LAS f32x4*)(red + (F.wave * 9 + r) * 256 + F.lane * 4) = a[r];
        __syncthreads();
        for (int i = F.tid; i < 9 * 256; i += NTHR) { const int r = i >> 8, c = i & 255; float sm = 0.f;
#pragma unroll
            for (int w = 0; w < 8; ++w) sm += red[(w * 9 + r) * 256 + c];
            const int col = (u % 36) * 256 + c;
            WSP(float, WS_MOD)[(size_t)(l * 9 + r) * MODW + col] = sm + INP(I_BADA)[l * MODW + col]; }
        __syncthreads();
    }
    }
    float* rope = WSP(float, WS_ROPE);
    for (int i = F.bid * NTHR + F.tid; i < 2048 * 16; i += F.G * NTHR) { const int t = i >> 4, j = i & 15; const float pos = (float)(j < 8 ? (t >> 6) : (t & 63));
        const float inv = powf(10000.0f, -(float)(j & 7) * 0.125f); const float ang = pos * inv; rope[2 * i] = cosf(ang); rope[2 * i + 1] = sinf(ang); }
}

template <class Map> __device__ __forceinline__ void shw_unit(const Frame& F, const float* W, int Nsrc, const float* shift  , float* out  , int Ndst, int cg, Map map) {
    LAS float* sc = (LAS float*)(F.lds);
    LAS float* red = (LAS float*)(F.lds + 32768);
    __syncthreads();
    for (int i = F.tid; i < 8 * 1024; i += NTHR) sc[i] = shift[(size_t)(i >> 10) * MODW + (i & 1023)];
    __syncthreads();
    const int n0 = cg * 256 + F.lane * 4, scol = map(n0); const float* Wp = W + (scol < 0 ? 0 : scol);
    f32x4 a[8];
#pragma unroll
    for (int r = 0; r < 8; ++r) a[r] = (f32x4){0.f, 0.f, 0.f, 0.f};
    const int kb = F.wave * 128;
    for (int k0 = kb; k0 < kb + 128; k0 += 8) { f32x4 w[8];
#pragma unroll
        for (int i = 0; i < 8; ++i) w[i] = *(const f32x4*)(Wp + (size_t)(k0 + i) * Nsrc);
#pragma unroll
        for (int i = 0; i < 8; ++i)
#pragma unroll
            for (int r = 0; r < 8; ++r) a[r] += w[i] * sc[r * 1024 + k0 + i]; }
    if (scol < 0) {
#pragma unroll
        for (int r = 0; r < 8; ++r) a[r] = (f32x4){0.f, 0.f, 0.f, 0.f}; }
#pragma unroll
    for (int r = 0; r < 8; ++r) *(LAS f32x4*)(red + (F.wave * 8 + r) * 256 + F.lane * 4) = a[r];
    __syncthreads();
    for (int i = F.tid; i < 8 * 256; i += NTHR) { const int r = i >> 8, c = i & 255; float sm = 0.f;
#pragma unroll
        for (int w = 0; w < 8; ++w) sm += red[(w * 8 + r) * 256 + c];
        out[(size_t)r * Ndst + cg * 256 + c] = sm; }
}
__device__ __forceinline__ void shw_phase(const Frame& F) {
    for (int u = F.bid; u < 136; u += F.G) {
        const int l = u / 68, v = u % 68; const float* modl = WSP(float, WS_MOD) + (size_t)l * 9 * MODW; float* shw = WSP(float, WS_SHW) + (size_t)l * SHW_LAYER;
        if (v < 22) shw_unit(F, INP(I_F1WI) + (size_t)l * DM * 2 * DFF, 2 * DFF, modl + 0 * DM, shw + SHW_F1, 2 * DFF, v, MapFfnIn{});
        else if (v < 34) shw_unit(F, INP(I_WIN) + (size_t)l * DM * DIN, DIN, modl + 3 * DM, shw + SHW_INA, 3072, v - 22, MapInA{});
        else if (v < 46) shw_unit(F, INP(I_WIN) + (size_t)l * DM * DIN, DIN, modl + 3 * DM, shw + SHW_GATE, 3072, v - 34, MapOff{2992});
        else shw_unit(F, INP(I_F2WI) + (size_t)l * DM * 2 * DFF, 2 * DFF, modl + 6 * DM, shw + SHW_F2, 2 * DFF, v - 46, MapFfnIn{});
    }
}

__device__ __forceinline__ void norm_phase(const Frame& F, int l, int which, bool lat_in, bool ctx_in, int row0, int nrows, int nslabs, bf16* H) {
    const int gw = F.vcu * NWAVES + F.wave, NGW = F.G * NWAVES;
    const float* g = INP(I_NORMG) + (l * 3 + which) * DM; const float* slab = WSP(float, B_SLAB);
    f32x4 v[4], nv[4];
    int row = row0 + gw;
    if (row < nrows) { const f32x4* xr = (const f32x4*)xrow_in(F, row, row < NLAT ? lat_in : ctx_in) + F.lane;
#pragma unroll
        for (int j = 0; j < 4; ++j) nv[j] = xr[64 * j]; }
    for (; row < nrows; row += NGW) {
#pragma unroll
        for (int j = 0; j < 4; ++j) v[j] = nv[j];
        const int nrow = row + NGW;
        if (nrow < nrows) { const f32x4* xr = (const f32x4*)xrow_in(F, nrow, nrow < NLAT ? lat_in : ctx_in) + F.lane;
#pragma unroll
            for (int j = 0; j < 4; ++j) nv[j] = xr[64 * j]; }
        if (nslabs > 0 && row >= NLAT) {
            f32x4 sv[4][4];
#pragma unroll
            for (int sidx = 0; sidx < 4; ++sidx) { const f32x4* sr = (const f32x4*)(slab + ((size_t)sidx * NCTX + (row - NLAT)) * DM) + F.lane;
#pragma unroll
                for (int j = 0; j < 4; ++j) sv[sidx][j] = sr[64 * j]; }
#pragma unroll
            for (int sidx = 0; sidx < 4; ++sidx)
#pragma unroll
                for (int j = 0; j < 4; ++j) v[j] += sv[sidx][j];
            f32x4* xo = (f32x4*)xrow_out(F, row) + F.lane;
#pragma unroll
            for (int j = 0; j < 4; ++j) xo[64 * j] = v[j];
        }
        if (lat_in && row < NLAT) { u32x2* xb = (u32x2*)(XBP + (size_t)row * DM) + F.lane;
#pragma unroll
            for (int j = 0; j < 4; ++j) xb[64 * j] = xs_pack(v[j]); }
        const float* mod = WSP(float, WS_MOD) + (size_t)(l * 9 + mod_row(row)) * MODW + (3 * which) * DM;
        float sq = 0.f;
#pragma unroll
        for (int j = 0; j < 4; ++j) sq += (v[j][0] * v[j][0] + v[j][1] * v[j][1]) + (v[j][2] * v[j][2] + v[j][3] * v[j][3]);
        const float r = rsqf_(wave_sum(sq) * (1.f / DM) + EPS);
        u32x2* o = (u32x2*)(H + (size_t)row * DM) + F.lane;
#pragma unroll
        for (int j = 0; j < 4; ++j) { const int c = 4 * F.lane + 256 * j; const f32x4 gg = *(const f32x4*)(g + c), sh = *(const f32x4*)(mod + c), scl = *(const f32x4*)(mod + DM + c);
            const f32x4 y = v[j] * r * gg * (scl + 1.0f) + sh; u32x2 w; w.x = pk2(y[0], y[1]); w.y = pk2(y[2], y[3]); o[64 * j] = w; }
    }
}
__device__ __forceinline__ void zero_stats(const Frame& F) {
    float* st = WSP(float, WS_STAT);
    for (int i = F.bid * NTHR + F.tid; i < 4 * NTOK; i += F.G * NTHR) st[i] = 0.f;
}
__device__ __forceinline__ void merge_ctx_sum(const Frame& F) {
    const int gw = F.vcu * NWAVES + F.wave, NGW = F.G * NWAVES; const float* slab = WSP(float, B_MSLAB); bf16* MG = WSP(bf16, WS_H) + (size_t)NLAT * DM;
    for (int row = gw; row < NCTX; row += NGW) {
#pragma unroll
        for (int j = 0; j < 4; ++j) { const size_t o = (size_t)row * DM + 4 * F.lane + 256 * j;
            const f32x4 v = *(const f32x4*)(slab + o) + *(const f32x4*)(slab + (size_t)NCTX * DM + o) + *(const f32x4*)(slab + 2 * (size_t)NCTX * DM + o);
            u32x2 w; w.x = pk2(v[0], v[1]); w.y = pk2(v[2], v[3]); *(u32x2*)(MG + o) = w; }
    }
}
__device__ __forceinline__ void zero_rssn(const Frame& F, int first, int count) {
    float* st = WSP(float, WS_RSSN) + (size_t)first * NLAT;
    for (int i = F.bid * NTHR + F.tid; i < count * NLAT; i += F.G * NTHR) st[i] = 0.f;
}
__device__ __forceinline__ void final_norm(const Frame& F) {
    const int gw = F.vcu * NWAVES + F.wave, NGW = F.G * NWAVES; const float* g = INP(I_FNORM);
    f32x4 gg[4];
#pragma unroll
    for (int j = 0; j < 4; ++j) gg[j] = *(const f32x4*)(g + 4 * F.lane + 256 * j);
    constexpr int NR = 4;
    for (int row0 = gw; row0 < NLAT; row0 += NR * NGW) {
        u32x2 raw[NR][4];
#pragma unroll
        for (int k = 0; k < NR; ++k) { const int row = row0 + k * NGW < NLAT ? row0 + k * NGW : row0; const u32x2* xr = (const u32x2*)(WSP(bf16, B_XF) + (size_t)row * DM) + F.lane;
#pragma unroll
            for (int j = 0; j < 4; ++j) raw[k][j] = xr[64 * j]; }
        f32x4 v[NR][4]; float s[NR];
#pragma unroll
        for (int k = 0; k < NR; ++k) { s[k] = 0.f;
#pragma unroll
            for (int j = 0; j < 4; ++j) { v[k][j] = xs_unpack(raw[k][j]); s[k] += (v[k][j][0] * v[k][j][0] + v[k][j][1] * v[k][j][1]) + (v[k][j][2] * v[k][j][2] + v[k][j][3] * v[k][j][3]); } }
#pragma unroll
        for (int o = 1; o < 64; o <<= 1) {
#pragma unroll
            for (int k = 0; k < NR; ++k) s[k] += __shfl_xor(s[k], o); }
#pragma unroll
        for (int k = 0; k < NR; ++k) { const int row = row0 + k * NGW; if (row < NLAT) { const float r = 1.0f / sqrtf(s[k] * (1.f / DM) + EPS); f32x4* xw = (f32x4*)(OUTP + (size_t)row * DM) + F.lane;
#pragma unroll
            for (int j = 0; j < 4; ++j) xw[64 * j] = v[k][j] * r * gg[j]; } }
    }
}
__device__ __forceinline__ void conv_phase(const Frame& F, int l, int nrows) {
    const bf16* src = WSP(bf16, B_XBCR); bf16* dst = WSP(bf16, B_XBC);
    const float* cw = INP(I_CONVW) + (size_t)l * 1024 * 5; const float* cb = INP(I_CONVB) + l * 1024;
    const int nitems = (nrows / 8) * 128;
    for (int it = F.bid * NTHR + F.tid; it < nitems; it += F.G * NTHR) {
        const int cg = it & 127, rb = it >> 7, c0 = cg * 8, R = rb * 8;
        int s0, s1; if (R < NLAT) { s0 = R & ~2047; s1 = s0 + 2048; } else { s0 = NLAT + ((R - NLAT) & ~255); s1 = s0 + 256; }
        u32x4 raw[12];
#pragma unroll
        for (int k = 0; k < 12; ++k) { const int r = R - 2 + k; raw[k] = (u32x4){0u, 0u, 0u, 0u}; if (r >= s0 && r < s1) raw[k] = *(const u32x4*)(src + (size_t)r * 1024 + c0); }
        float wf[40];
#pragma unroll
        for (int q = 0; q < 10; ++q) { const f32x4 t = *(const f32x4*)(cw + (size_t)c0 * 5 + 4 * q); wf[4 * q] = t[0]; wf[4 * q + 1] = t[1]; wf[4 * q + 2] = t[2]; wf[4 * q + 3] = t[3]; }
        f32x4 wv[5][2];
#pragma unroll
        for (int k = 0; k < 5; ++k)
#pragma unroll
            for (int h2 = 0; h2 < 2; ++h2) wv[k][h2] = (f32x4){wf[(4 * h2) * 5 + k], wf[(4 * h2 + 1) * 5 + k], wf[(4 * h2 + 2) * 5 + k], wf[(4 * h2 + 3) * 5 + k]};
        const f32x4 b0 = *(const f32x4*)(cb + c0), b1 = *(const f32x4*)(cb + c0 + 4);
        f32x4 acc[8][2];
#pragma unroll
        for (int o = 0; o < 8; ++o) { acc[o][0] = b0; acc[o][1] = b1; }
#pragma unroll
        for (int k = 0; k < 12; ++k) { float x[8]; unpack8(raw[k], x); const f32x4 x0 = (f32x4){x[0], x[1], x[2], x[3]}, x1 = (f32x4){x[4], x[5], x[6], x[7]};
#pragma unroll
            for (int o = 0; o < 8; ++o) { const int tap = k - o;
                if (tap >= 0 && tap < 5) { acc[o][0] += wv[tap][0] * x0; acc[o][1] += wv[tap][1] * x1; } } }
#pragma unroll
        for (int o = 0; o < 8; ++o) { const u32x4 ov = pack8(silu4(acc[o][0]), silu4(acc[o][1]));
            *(u32x4*)(dst + (size_t)(R + o) * 1024 + c0) = ov; }
    }
}
__device__ __forceinline__ void ssm_out_prep(const Frame& F, int l, int nrows) {
    const int gw = F.vcu * NWAVES + F.wave, NGW = F.G * NWAVES; const float* g = INP(I_SSMNORM) + l * 512;
    bf16* YF = WSP(bf16, B_YF); const bf16* YB = WSP(bf16, B_YB); const bf16* SZ = WSP(bf16, B_SZ);
    float gg[8];
#pragma unroll
    for (int c = 0; c < 8; ++c) gg[c] = g[F.lane * 8 + c];
    for (int row0 = gw; row0 < nrows; row0 += 3 * NGW) {
        u32x4 ra[3], rb[3], rz[3];
#pragma unroll
        for (int k = 0; k < 3; ++k) { const int row = row0 + k * NGW; const size_t o = (size_t)(row < nrows ? row : row0) * 512 + F.lane * 8; ra[k] = *(const u32x4*)(YF + o); rb[k] = *(const u32x4*)(YB + o); rz[k] = *(const u32x4*)(SZ + o); }
        float a[3][8], s[3];
#pragma unroll
        for (int k = 0; k < 3; ++k) { float b[8], z[8]; unpack8(ra[k], a[k]); unpack8(rb[k], b); unpack8(rz[k], z); s[k] = 0.f;
#pragma unroll
            for (int c = 0; c < 8; ++c) { a[k][c] = (a[k][c] + b[c]) * z[c]; s[k] += a[k][c] * a[k][c]; } }
#pragma unroll
        for (int o = 1; o < 64; o <<= 1) {
#pragma unroll
            for (int k = 0; k < 3; ++k) s[k] += __shfl_xor(s[k], o); }
#pragma unroll
        for (int k = 0; k < 3; ++k) { const int row = row0 + k * NGW; if (row < nrows) { const float r = 1.0f / sqrtf(s[k] * (1.f / 512.f) + EPS);
            u32x4 ov; ov.x = pk2(a[k][0] * r * gg[0], a[k][1] * r * gg[1]); ov.y = pk2(a[k][2] * r * gg[2], a[k][3] * r * gg[3]); ov.z = pk2(a[k][4] * r * gg[4], a[k][5] * r * gg[5]); ov.w = pk2(a[k][6] * r * gg[6], a[k][7] * r * gg[7]);
            *(u32x4*)(YF + (size_t)row * 512 + F.lane * 8) = ov; } }
    }
}

#define EPI_RED_OFF 131072
__device__ __forceinline__ void epi_row_atomics(const float (&pa)[8], const float (&pb)[8], float* dsta, float* dstb  , int wr, int wc, int fr, int fq, int tid) {
    LAS float* red = (LAS float*)(unsigned)EPI_RED_OFF;
    if (fq == 0) {
#pragma unroll
        for (int i = 0; i < 8; ++i) { const int o = wc * 256 + (i >> 2) * 128 + wr * 64 + (i & 3) * 16 + fr; red[o] = pa[i]; if (dstb) red[1024 + o] = pb[i]; } }
    asm volatile("s_waitcnt lgkmcnt(0)" ::: "memory"); __builtin_amdgcn_s_barrier(); asm volatile("" ::: "memory");
    if (tid < 256) { const float v = (red[tid] + red[256 + tid]) + (red[512 + tid] + red[768 + tid]); atomicAdd(dsta + tid, v); }
    else if (dstb) { const int t = tid - 256; const float v = (red[1024 + t] + red[1280 + t]) + (red[1536 + t] + red[1792 + t]); atomicAdd(dstb + t, v); }
}
struct EpiSwiglu {
    static constexpr bool PERM = true, AFTER_DRAIN = false;
    bf16* ACT; const float* rss; const float* shw; int fused;
    __device__ __forceinline__ void operator()(const f32x4 (&acc)[2][2][4][2], const pg8::Unit& u, int wr, int wc, int fr, int fq) const {
        asm volatile("" : "+v"(fr), "+v"(fq));
        bf16* act_ = ACT; const bool fz = fused && (u.pm * 256 < NLAT);
        const int oc = u.pn * 128 + wc * 32 + 8 * fq, row0 = u.pm * 256 + wr * 64 + fr;
        f32x4 sh[4]; float rr[8];
#pragma unroll
        for (int i = 0; i < 4; ++i) sh[i] = (f32x4){0.f, 0.f, 0.f, 0.f};
#pragma unroll
        for (int i = 0; i < 8; ++i) rr[i] = 1.f;
        if (fz) { const float* sp = shw + (size_t)(u.pm >> 3) * (2 * DFF) + u.pn * 256 + wc * 32 + 8 * fq; sh[0] = *(const f32x4*)(sp); sh[1] = *(const f32x4*)(sp + 4); sh[2] = *(const f32x4*)(sp + 128); sh[3] = *(const f32x4*)(sp + 132);
#pragma unroll
            for (int i = 0; i < 8; ++i) rr[i] = rss[row0 + (i >> 2) * 128 + (i & 3) * 16];
#pragma unroll
            for (int i = 0; i < 8; ++i) rr[i] = rsqf_(rr[i] * (1.f / DM) + EPS); }
        constexpr float CG = -1.4426950408889634f, CU = -0.6931471805599453f;
        sh[0] *= CG; sh[1] *= CG; sh[2] *= CU; sh[3] *= CU;
#pragma unroll
        for (int ai = 0; ai < 2; ++ai)
#pragma unroll
            for (int m = 0; m < 4; ++m) { const int row = row0 + ai * 128 + m * 16; const float rg = rr[ai * 4 + m] * CG, ru = rr[ai * 4 + m] * CU;
                const f32x4 g0 = acc[ai][0][m][0] * rg + sh[0], g1 = acc[ai][0][m][1] * rg + sh[1], u0 = acc[ai][1][m][0] * ru + sh[2], u1 = acc[ai][1][m][1] * ru + sh[3];
                f32x4 e0, e1;
#pragma unroll
                for (int j = 0; j < 4; ++j) { e0[j] = __builtin_amdgcn_exp2f(g0[j]); e1[j] = __builtin_amdgcn_exp2f(g1[j]); }
                e0 = e0 + 1.0f; e1 = e1 + 1.0f;
#pragma unroll
                for (int j = 0; j < 4; ++j) { e0[j] = rcpf_(e0[j]); e1[j] = rcpf_(e1[j]); }
                const f32x4 a0 = g0 * u0 * e0, a1 = g1 * u1 * e1;
                *(u32x4*)(act_ + (size_t)row * DFF + oc) = pack8(a0, a1); }
    }
};
struct FResid { const bf16* xb; bf16* out; const float* mod; int gate_idx; float coef;
    __device__ __forceinline__ void operator()(int row, int col, f32x4 v0, f32x4 v1) const {
        const bf16* a_ = xb; bf16* o_ = out; const float* m_ = mod; const int gi = gate_idx; const float cf = coef;
        const size_t off = (size_t)row * DM + col;
        const float* gp = m_ + (size_t)mod_row(row) * MODW + gi * DM + col;
        const f32x4 g0 = *(const f32x4*)(gp), g1 = *(const f32x4*)(gp + 4);
        const u32x4 xo = *(const u32x4*)(a_ + off);
        const u32x2 p0 = xs_pack(xs_unpack((u32x2){xo.x, xo.y}) + g0 * v0 * cf), p1 = xs_pack(xs_unpack((u32x2){xo.z, xo.w}) + g1 * v1 * cf);
        *(u32x4*)(o_ + off) = (u32x4){p0.x, p0.y, p1.x, p1.y};
    } };
struct EpiResidN {
    static constexpr bool PERM = true, AFTER_DRAIN = false;
    bf16* xs; const float* mod; const float* modn; const float* gnorm; float* rss; bf16* Hn; int gate_idx, which_next; float coef;
    __device__ __forceinline__ void operator()(const f32x4 (&acc)[2][2][4][2], const pg8::Unit& u, int wr, int wc, int fr, int fq) const {
        asm volatile("" : "+v"(fr), "+v"(fq));
        bf16* x_ = xs; bf16* h_ = Hn; float* rss_ = rss; const float cf = coef;
        const int b = u.pm >> 3, c0 = u.pn * 256 + wc * 32 + 8 * fq, row0 = u.pm * 256 + wr * 64 + fr;
        float part[8]; const int tid_ = (wr * 4 + wc) * 64 + fq * 16 + fr;
#pragma unroll
        for (int q = 0; q < 8; ++q) part[q] = 0.f;
#pragma unroll
        for (int bj = 0; bj < 2; ++bj) {
            f32x4 gt[2], gs[2];
#pragma unroll
            for (int n = 0; n < 2; ++n) { const int col = c0 + bj * 128 + n * 4;
                gt[n] = *(const f32x4*)(mod + (size_t)b * MODW + gate_idx * DM + col) * cf;
                gs[n] = *(const f32x4*)(gnorm + col) * (*(const f32x4*)(modn + (size_t)b * MODW + (3 * which_next + 1) * DM + col) + 1.0f); }
#pragma unroll
            for (int ai = 0; ai < 2; ++ai) {
            u32x4 xo[4];
#pragma unroll
            for (int m = 0; m < 4; ++m) xo[m] = *(const u32x4*)(x_ + (size_t)(row0 + ai * 128 + m * 16) * DM + c0 + bj * 128);
#pragma unroll
            for (int m = 0; m < 4; ++m) { const int q = ai * 4 + m; const size_t ro = (size_t)(row0 + ai * 128 + m * 16) * DM + c0 + bj * 128;
                const f32x4 xa = xs_unpack((u32x2){xo[m].x, xo[m].y}) + gt[0] * acc[ai][bj][m][0], xb = xs_unpack((u32x2){xo[m].z, xo[m].w}) + gt[1] * acc[ai][bj][m][1];
                const u32x2 pa = xs_pack(xa), pb = xs_pack(xb);
                *(u32x4*)(x_ + ro) = (u32x4){pa.x, pa.y, pb.x, pb.y};
                part[q] += ((xa[0] * xa[0] + xa[1] * xa[1]) + (xa[2] * xa[2] + xa[3] * xa[3])) + ((xb[0] * xb[0] + xb[1] * xb[1]) + (xb[2] * xb[2] + xb[3] * xb[3]));
                *(u32x4*)(h_ + ro) = pack8(xa * gs[0], xb * gs[1]); } }
        }
#pragma unroll
        for (int q = 0; q < 8; ++q) part[q] = sum_fq(part[q]);
        epi_row_atomics(part, part, rss_ + u.pm * 256, nullptr, wr, wc, fr, fq, tid_);
    }
};
struct EpiSlab {
    static constexpr bool PERM = false, AFTER_DRAIN = false;
    float* slab; const float* mod; int gate_idx, ks0; float coef;
    __device__ __forceinline__ void operator()(const f32x4 (&acc)[2][2][4][2], const pg8::Unit& u, int wr, int wc, int fr, int fq) const {
        asm volatile("" : "+v"(fr), "+v"(fq));
        float* sl = slab + (size_t)(ks0 + u.ks) * NCTX * DM; const float* md = mod + (size_t)8 * MODW + gate_idx * DM; const float cf = coef;
#pragma unroll
        for (int ai = 0; ai < 2; ++ai)
#pragma unroll
            for (int m = 0; m < 4; ++m) { const int row = u.pm * 256 + ai * 128 + wr * 64 + m * 16 + fr;
#pragma unroll
                for (int bj = 0; bj < 2; ++bj)
#pragma unroll
                    for (int n = 0; n < 2; ++n) { const int col = u.pn * 256 + bj * 128 + wc * 32 + n * 16 + 4 * fq;
                        *(f32x4*)(sl + (size_t)row * DM + col) = *(const f32x4*)(md + col) * acc[ai][bj][m][n] * cf; } }
    }
};
struct EpiGates {
    static constexpr bool PERM = true, AFTER_DRAIN = false;
    bf16* GATES; const float* bg; const float* rss; const float* shw;
    __device__ __forceinline__ void operator()(const f32x4 (&acc)[2][2][4][2], const pg8::Unit& u, int wr, int wc, int fr, int fq) const {
        asm volatile("" : "+v"(fr), "+v"(fq));
        bf16* gt_ = GATES; const bool fz = (u.pm * 256 < NLAT);
        const int c0 = u.pn * 256 + wc * 32 + 8 * fq, row0 = u.pm * 256 + wr * 64 + fr;
        f32x4 sh[2][2]; float rr[8];
#pragma unroll
        for (int bj = 0; bj < 2; ++bj) { sh[bj][0] = *(const f32x4*)(bg + c0 + bj * 128); sh[bj][1] = *(const f32x4*)(bg + c0 + bj * 128 + 4); }
#pragma unroll
        for (int i = 0; i < 8; ++i) rr[i] = 1.f;
        if (fz) { const float* sp = shw + (size_t)(u.pm >> 3) * 3072 + c0;
#pragma unroll
            for (int bj = 0; bj < 2; ++bj) { sh[bj][0] += *(const f32x4*)(sp + bj * 128); sh[bj][1] += *(const f32x4*)(sp + bj * 128 + 4); }
#pragma unroll
            for (int i = 0; i < 8; ++i) rr[i] = rss[row0 + (i >> 2) * 128 + (i & 3) * 16];
#pragma unroll
            for (int i = 0; i < 8; ++i) rr[i] = rsqf_(rr[i] * (1.f / DM) + EPS); }
#pragma unroll
        for (int bj = 0; bj < 2; ++bj) { sh[bj][0] *= -1.4426950408889634f; sh[bj][1] *= -1.4426950408889634f; }
#pragma unroll
        for (int ai = 0; ai < 2; ++ai)
#pragma unroll
            for (int m = 0; m < 4; ++m) { const int row = row0 + ai * 128 + m * 16; const float r = rr[ai * 4 + m] * -1.4426950408889634f;
#pragma unroll
                for (int bj = 0; bj < 2; ++bj) { const f32x4 a0 = rcp1p_exp2_4(acc[ai][bj][m][0] * r + sh[bj][0]), a1 = rcp1p_exp2_4(acc[ai][bj][m][1] * r + sh[bj][1]);
                    *(u32x4*)(gt_ + (size_t)row * 3072 + c0 + bj * 128) = pack8(a0, a1); } }
    }
};
struct EpiMergeChain {
    static constexpr bool PERM = true, AFTER_DRAIN = false;
    const bf16* GATES; bf16* MERGED;
    __device__ __forceinline__ void operator()(const f32x4 (&)[2][2][4][2], const pg8::Unit&, int, int, int, int) const {}
    __device__ __forceinline__ void chain(f32x4 (&acc)[2][2][4][2], const pg8::Unit& u, int wr, int wc, int fr, int fq) const {
        asm volatile("" : "+v"(fr), "+v"(fq));
        const bf16* gt_ = GATES; bf16* mg_ = MERGED; const int ks = u.ks;
        const int c0 = u.pn * 256 + wc * 32 + 8 * fq, row0 = u.pm * 256 + wr * 64 + fr;
#pragma unroll
        for (int ai = 0; ai < 2; ++ai) {
            u32x4 gn[4][2], gd[4][2];
#pragma unroll
            for (int m = 0; m < 4; ++m)
#pragma unroll
                for (int bj = 0; bj < 2; ++bj) { const bf16* gp = gt_ + (size_t)(row0 + ai * 128 + m * 16) * 3072 + c0 + bj * 128;
                    gn[m][bj] = *(const u32x4*)(gp + ks * 1024); gd[m][bj] = gn[m][bj]; if (ks < 2) gd[m][bj] = *(const u32x4*)(gp + (ks + 1) * 1024); }
#pragma unroll
            for (int m = 0; m < 4; ++m)
#pragma unroll
                for (int bj = 0; bj < 2; ++bj) { float f[8]; unpack8(gn[m][bj], f);
                    if (ks < 2) { float d[8]; unpack8(gd[m][bj], d);
#pragma unroll
                        for (int j = 0; j < 8; ++j) f[j] *= rcpf_(fmaxf(d[j], 1e-30f)); }
#pragma unroll
                    for (int j = 0; j < 4; ++j) { acc[ai][bj][m][0][j] *= f[j]; acc[ai][bj][m][1][j] *= f[4 + j]; }
                    if (ks == 2) *(u32x4*)(mg_ + (size_t)(row0 + ai * 128 + m * 16) * DM + c0 + bj * 128) = pack8(acc[ai][bj][m][0], acc[ai][bj][m][1]); }
        }
    }
};
struct EpiMergeSlab {
    static constexpr bool PERM = true, AFTER_DRAIN = false;
    const bf16* GATES; float* slab;
    __device__ __forceinline__ void operator()(const f32x4 (&acc)[2][2][4][2], const pg8::Unit& u, int wr, int wc, int fr, int fq) const {
        asm volatile("" : "+v"(fr), "+v"(fq));
        const bf16* gt_ = GATES + (size_t)NLAT * 3072 + u.ks * 1024; float* sl = slab + (size_t)u.ks * NCTX * DM;
        const int c0 = u.pn * 256 + wc * 32 + 8 * fq, row0 = u.pm * 256 + wr * 64 + fr;
#pragma unroll
        for (int ai = 0; ai < 2; ++ai)
#pragma unroll
            for (int m = 0; m < 4; ++m) { const int row = row0 + ai * 128 + m * 16;
#pragma unroll
                for (int bj = 0; bj < 2; ++bj) { float f[8]; unpack8(*(const u32x4*)(gt_ + (size_t)row * 3072 + c0 + bj * 128), f);
                    f32x4 o0, o1;
#pragma unroll
                    for (int j = 0; j < 4; ++j) { o0[j] = acc[ai][bj][m][0][j] * f[j]; o1[j] = acc[ai][bj][m][1][j] * f[4 + j]; }
                    *(f32x4*)(sl + (size_t)row * DM + c0 + bj * 128) = o0; *(f32x4*)(sl + (size_t)row * DM + c0 + bj * 128 + 4) = o1; } }
    }
};
struct FMerge { const bf16* GATES; bf16* MERGED; int br;
    __device__ __forceinline__ void operator()(int row, int col, f32x4 v0, f32x4 v1) const {
        float g[8]; unpack8(*(const u32x4*)(GATES + (size_t)row * 3072 + br * 1024 + col), g);
        float o[8];
#pragma unroll
        for (int j = 0; j < 4; ++j) { o[j] = g[j] * v0[j]; o[4 + j] = g[4 + j] * v1[j]; }
        if (br > 0) { float p[8]; unpack8(*(const u32x4*)(MERGED + (size_t)row * DM + col), p);
#pragma unroll
            for (int j = 0; j < 8; ++j) o[j] += p[j]; }
        u32x4 w; w.x = pk2(o[0], o[1]); w.y = pk2(o[2], o[3]); w.z = pk2(o[4], o[5]); w.w = pk2(o[6], o[7]);
        *(u32x4*)(MERGED + (size_t)row * DM + col) = w;
    } };
struct FKvUp { unsigned char* ws;
    __device__ __forceinline__ void operator()(int row, int col, f32x4 v0, f32x4 v1) const {
        unsigned char* w_ = ws; const float* rss = (const float*)(w_ + WS_STAT);
        const float r = rsqf_(rss[row] * (1.f / 128.f) + EPS);
        const int h = col >> 7, e = col & 127; const size_t boff = (e < 64 ? B_KN : B_V - 128) ;
        bf16* dst = (bf16*)(w_ + boff) + (size_t)row * 512 + h * 64 + e;
        *(u32x4*)dst = pack8(v0 * r, v1 * r);
    } };
struct FQUp { unsigned char* ws;
    __device__ __forceinline__ void operator()(int row, int col, f32x4 v0, f32x4 v1) const {
        unsigned char* w_ = ws; const float* rss = (const float*)(w_ + WS_STAT) + NTOK; const float* rope = (const float*)(w_ + WS_ROPE); bf16* Q = (bf16*)(w_ + B_Q);
        const float r = QSCALE * rsqf_(rss[row] * (1.f / 256.f) + EPS);
        v0 = v0 * r; v1 = v1 * r;
        if (col < 512) { const int h = col >> 6, d = col & 63; *(u32x4*)(Q + (size_t)row * 768 + h * 96 + d) = pack8(v0, v1); }
        else { const int c = col - 512, h = c >> 5, i0 = ((c & 31) >> 3) * 4;
            f32x4 o1 = v0, o2 = v1;
            if (row < NLAT) { const float* cs = rope + ((size_t)(row & 2047) * 16 + i0) * 2;
#pragma unroll
                for (int j = 0; j < 4; ++j) { const float c_ = cs[2 * j], s_ = cs[2 * j + 1]; o1[j] = v0[j] * c_ - v1[j] * s_; o2[j] = v0[j] * s_ + v1[j] * c_; } }
            bf16* q = Q + (size_t)row * 768 + h * 96 + 64 + i0; u32x2 w1, w2; w1.x = pk2(o1[0], o1[1]); w1.y = pk2(o1[2], o1[3]); w2.x = pk2(o2[0], o2[1]); w2.y = pk2(o2[2], o2[3]);
            *(u32x2*)q = w1; *(u32x2*)(q + 16) = w2; }
    } };

struct EpiInA {
    static constexpr bool PERM = true, AFTER_DRAIN = false;
    int row_off; unsigned char* ws; const float* dtb_; int shw_layer;
    __device__ __forceinline__ void operator()(const f32x4 (&acc_)[2][2][4][2], const pg8::Unit& u, int wr, int wc, int fr, int fq) const {
        asm volatile("" : "+v"(fr), "+v"(fq));
        const int pn = u.pn; unsigned char* w_ = ws; const float* dtb = dtb_;
        float pA[8], pB[8]; const int tid_ = (wr * 4 + wc) * 64 + fq * 16 + fr; const int rowt = row_off + u.pm * 256;
#pragma unroll
        for (int i = 0; i < 8; ++i) { pA[i] = 0.f; pB[i] = 0.f; }
        const bool latt = (row_off + u.pm * 256) < NLAT;
        f32x4 shv[2][2]; float rrv[8];
#pragma unroll
        for (int bj = 0; bj < 2; ++bj) { shv[bj][0] = (f32x4){0.f, 0.f, 0.f, 0.f}; shv[bj][1] = (f32x4){0.f, 0.f, 0.f, 0.f}; }
#pragma unroll
        for (int i = 0; i < 8; ++i) rrv[i] = 1.f;
        if (latt) { const float* sp = (const float*)(w_ + WS_SHW) + shw_layer + SHW_INA + (size_t)(u.pm >> 3) * 3072 + pn * 256 + wc * 32 + 8 * fq;
#pragma unroll
            for (int bj = 0; bj < 2; ++bj) { shv[bj][0] = *(const f32x4*)(sp + bj * 128); shv[bj][1] = *(const f32x4*)(sp + bj * 128 + 4); }
            const float* rp = (const float*)(w_ + WS_RSSN) + NLAT + u.pm * 256 + wr * 64 + fr;
#pragma unroll
            for (int i = 0; i < 8; ++i) rrv[i] = rp[(i >> 2) * 128 + (i & 3) * 16];
#pragma unroll
            for (int i = 0; i < 8; ++i) rrv[i] = rsqf_(rrv[i] * (1.f / DM) + EPS); }
        bf16* KVR = (bf16*)(w_ + B_KVR); bf16* KRP = (bf16*)(w_ + B_KRP); bf16* XBCR = (bf16*)(w_ + B_XBCR); bf16* QLAT = (bf16*)(w_ + B_QLAT); bf16* SZ = (bf16*)(w_ + B_SZ); bf16* UV = (bf16*)(w_ + B_UV);
        float* DT = (float*)(w_ + B_DT); float* RSSKV = (float*)(w_ + WS_STAT); float* RSSQ = RSSKV + NTOK; float* VSUM = RSSKV + 2 * NTOK; float* VSQ = RSSKV + 3 * NTOK; const float* rope = (const float*)(w_ + WS_ROPE);
#pragma unroll
        for (int ai = 0; ai < 2; ++ai)
#pragma unroll
            for (int m = 0; m < 4; ++m) {
                const int row = row_off + u.pm * 256 + ai * 128 + wr * 64 + m * 16 + fr;
                const int cw = wc * 32 + 8 * fq;
                const int ai_ = ai, m_ = m;
                f32x4 acc[1][2][1][2];
                { const float r = rrv[ai * 4 + m];
#pragma unroll
                  for (int bj = 0; bj < 2; ++bj)
#pragma unroll
                      for (int n = 0; n < 2; ++n) acc[0][bj][0][n] = acc_[ai][bj][m][n] * r + shv[bj][n]; }
#define ai 0
#define m 0
                if (pn == 0) {
                    const f32x4 v0 = acc[ai][0][m][0], v1 = acc[ai][0][m][1], w0 = acc[ai][1][m][0], w1 = acc[ai][1][m][1];
                    *(u32x4*)(KVR + (size_t)row * 256 + cw) = pack8(v0, v1);
                    *(u32x4*)(KVR + (size_t)row * 256 + 128 + cw) = pack8(w0, w1);
                    float ss = (v0[0] * v0[0] + v0[1] * v0[1]) + (v0[2] * v0[2] + v0[3] * v0[3]) + (v1[0] * v1[0] + v1[1] * v1[1]) + (v1[2] * v1[2] + v1[3] * v1[3]);
                    pA[ai_ * 4 + m_] = sum_fq(ss);
                    if (wc == 0) {
                        f32x4 o1 = w0, o2 = w1; const int i0 = 4 * fq;
                        if (row < NLAT) { const float* cs = rope + ((size_t)(row & 2047) * 16 + i0) * 2;
#pragma unroll
                            for (int j = 0; j < 4; ++j) { const float c_ = cs[2 * j], s_ = cs[2 * j + 1]; o1[j] = w0[j] * c_ - w1[j] * s_; o2[j] = w0[j] * s_ + w1[j] * c_; } }
                        u32x2 a, b; a.x = pk2(o1[0], o1[1]); a.y = pk2(o1[2], o1[3]); b.x = pk2(o2[0], o2[1]); b.y = pk2(o2[2], o2[3]);
                        *(u32x2*)(KRP + (size_t)row * 32 + i0) = a; *(u32x2*)(KRP + (size_t)row * 32 + 16 + i0) = b;
                    } else if (wc == 1 && fq < 2) {
                        f32x4 d0, d1;
#pragma unroll
                        for (int j = 0; j < 4; ++j) { d0[j] = softplusf_(w0[j] + dtb[fq * 8 + j]); d1[j] = softplusf_(w1[j] + dtb[fq * 8 + 4 + j]); }
                        *(f32x4*)(DT + (size_t)row * 16 + fq * 8) = d0; *(f32x4*)(DT + (size_t)row * 16 + fq * 8 + 4) = d1;
                    }
                } else if (pn <= 4) {
#pragma unroll
                    for (int bj = 0; bj < 2; ++bj) *(u32x4*)(XBCR + (size_t)row * 1024 + (pn - 1) * 256 + bj * 128 + cw) = pack8(acc[ai][bj][m][0], acc[ai][bj][m][1]);
                } else if (pn == 5) {
                    float ss = 0.f;
#pragma unroll
                    for (int bj = 0; bj < 2; ++bj) { const f32x4 v0 = acc[ai][bj][m][0], v1 = acc[ai][bj][m][1];
                        *(u32x4*)(QLAT + (size_t)row * 256 + bj * 128 + cw) = pack8(v0, v1);
                        ss += (v0[0] * v0[0] + v0[1] * v0[1]) + (v0[2] * v0[2] + v0[3] * v0[3]) + (v1[0] * v1[0] + v1[1] * v1[1]) + (v1[2] * v1[2] + v1[3] * v1[3]); }
                    pA[ai_ * 4 + m_] = sum_fq(ss);
                } else if (pn <= 7) {
#pragma unroll
                    for (int bj = 0; bj < 2; ++bj) { const f32x4 a0 = silu4(acc[ai][bj][m][0]), a1 = silu4(acc[ai][bj][m][1]);
                        *(u32x4*)(SZ + (size_t)row * 512 + (pn - 6) * 256 + bj * 128 + cw) = pack8(a0, a1); }
                } else {
                    float s = 0.f, ss = 0.f;
#pragma unroll
                    for (int bj = 0; bj < 2; ++bj) { const f32x4 a0 = gelu_tanh4(acc[ai][bj][m][0]), a1 = gelu_tanh4(acc[ai][bj][m][1]);
#pragma unroll
                        for (int j = 0; j < 4; ++j) { s += a0[j] + a1[j]; ss += a0[j] * a0[j] + a1[j] * a1[j]; }
                        *(u32x4*)(UV + (size_t)row * 1024 + (pn - 8) * 256 + bj * 128 + cw) = pack8(a0, a1); }
                    if (pn >= 10) { pA[ai_ * 4 + m_] = sum_fq(s); pB[ai_ * 4 + m_] = sum_fq(ss); }
                }
#undef ai
#undef m
            }
        if (pn == 0) epi_row_atomics(pA, pB, RSSKV + rowt, nullptr, wr, wc, fr, fq, tid_);
        else if (pn == 5) epi_row_atomics(pA, pB, RSSQ + rowt, nullptr, wr, wc, fr, fq, tid_);
        else if (pn >= 10) epi_row_atomics(pA, pB, VSUM + rowt, VSQ + rowt, wr, wc, fr, fq, tid_);
    }
};

typedef __attribute__((address_space(3))) const char* lds_cptr;
typedef short v4i16_t __attribute__((ext_vector_type(4)));
typedef short s16x4 __attribute__((ext_vector_type(4)));
__device__ __forceinline__ s16x4 vtr(lds_cptr p) { return __builtin_bit_cast(s16x4, __builtin_amdgcn_ds_read_tr16_b64_v4i16((__attribute__((address_space(3))) v4i16_t*)p)); }
__device__ __forceinline__ int crow(int r, int hi) { return (r & 3) + 8 * (r >> 2) + 4 * hi; }

#define ATT_THR 8.0f
#define ATT_SLOT 21504
__device__ __forceinline__ void glds16(const void* gsrc, unsigned lds_dst) { unsigned keep;
    asm volatile("s_mov_b32 %0, m0\n\ts_mov_b32 m0, %2\n\ts_nop 0\n\tglobal_load_lds_dwordx4 %1, off\n\ts_mov_b32 m0, %0" : "=&s"(keep) : "v"(gsrc), "s"(lds_dst) : "memory"); }
__device__ __forceinline__ float att_rowmax(const f32x16& p0, const f32x16& p1) {
    float mx = fmaxf(p0[0], p1[0]);
#pragma unroll
    for (int r = 1; r < 16; ++r) mx = fmaxf(fmaxf(mx, p0[r]), p1[r]);
    return max_x32(mx);
}
template <int NB, int VAR = 0> __device__ __forceinline__ void attn_unit(const Frame& F, int h, int qrow0, int seg0_row, int seg0_tiles, int seg1_row, int seg1_tiles, bf16* AOover = nullptr) {
    static_assert(NB == 1, "one 32-row query block per wave");
    const bf16* Q = WSP(bf16, B_Q); bf16* AO = AOover ? AOover : WSP(bf16, B_AMLA);
    int lane = F.lane; asm volatile("" : "+v"(lane));
    const int wid = F.wave, r32 = lane & 31, hi = lane >> 5;
    LAS float* wsf = (LAS float*)(F.lds + 4 * ATT_SLOT) + wid * 128;
    bf16x8 qr[6];
    { const bf16* qp = Q + (size_t)(qrow0 + wid * 32 + r32) * 768 + h * 96 + hi * 8;
#pragma unroll
      for (int d0 = 0; d0 < 6; ++d0) qr[d0] = *(const bf16x8*)(qp + d0 * 16); }
    f32x16 o0 = {}, o1 = {}; float m_run = 0.f, l_run = 0.f;
    const int NT = seg0_tiles + seg1_tiles;
    unsigned dbase[3], dstride[3];
#pragma unroll
    for (int i = 0; i < 3; ++i) { const int j = wid + 8 * i;
        if (j < 13) { const int c = j * 64 + lane, row = c / 13, ch = c - row * 13;
            if (ch < 8) { dbase[i] = (unsigned)B_KN + (unsigned)(row * 512 + h * 64 + ch * 8) * 2u; dstride[i] = 1024u; }
            else if (ch < 12) { dbase[i] = (unsigned)B_KRP + (unsigned)(row * 32 + (ch - 8) * 8) * 2u; dstride[i] = 64u; }
            else { dbase[i] = (unsigned)B_KN + (unsigned)(row * 512) * 2u; dstride[i] = 1024u; } }
        else { const int c = (j - 13) * 64 + lane, dh = (c >> 8) & 1, key = (c >> 2) & 63, q = c & 3; dbase[i] = (unsigned)B_V + (unsigned)(key * 512 + h * 64 + dh * 32 + q * 8) * 2u; dstride[i] = 1024u; } }
    const unsigned char* wsb = WS_BASE; const unsigned lds0 = (unsigned)(uintptr_t)F.lds;
#define ATT_DMA(t_, slot_) do { const int t1_ = (t_); const unsigned rb_ = (unsigned)(t1_ < seg0_tiles ? seg0_row + t1_ * 64 : seg1_row + (t1_ - seg0_tiles) * 64); \
        _Pragma("unroll") for (int i = 0; i < 3; ++i) if (wid + 8 * i < 21) \
            glds16(wsb + (size_t)dbase[i] + (size_t)rb_ * dstride[i], (unsigned)__builtin_amdgcn_readfirstlane((int)(lds0 + (slot_) * ATT_SLOT + (wid + 8 * i) * 1024))); } while (0)
#define ATT_KLD(KT_) const LAS unsigned char* kt_ = (KT_) + r32 * 208 + hi * 16; do { \
        _Pragma("unroll") for (int d0 = 0; d0 < 4; ++d0) { ka[2 * d0] = *(const LAS bf16x8*)(kt_ + d0 * 32); ka[2 * d0 + 1] = *(const LAS bf16x8*)(kt_ + 32 * 208 + d0 * 32); } \
        __builtin_amdgcn_sched_barrier(0); } while (0)
#define ATT_QKM(P0, P1) do { \
        _Pragma("unroll") for (int d0 = 0; d0 < 4; ++d0) { \
            if (d0 == 0) { P0 = __builtin_amdgcn_mfma_f32_32x32x16_bf16(ka[0], qr[0], negm, 0, 0, 0); P1 = __builtin_amdgcn_mfma_f32_32x32x16_bf16(ka[1], qr[0], negm, 0, 0, 0); } \
            else { P0 = __builtin_amdgcn_mfma_f32_32x32x16_bf16(ka[2 * d0], qr[d0], P0, 0, 0, 0); P1 = __builtin_amdgcn_mfma_f32_32x32x16_bf16(ka[2 * d0 + 1], qr[d0], P1, 0, 0, 0); } } \
        _Pragma("unroll") for (int d0 = 4; d0 < 6; ++d0) { const bf16x8 k0_ = *(const LAS bf16x8*)(kt_ + d0 * 32), k1_ = *(const LAS bf16x8*)(kt_ + 32 * 208 + d0 * 32); \
            P0 = __builtin_amdgcn_mfma_f32_32x32x16_bf16(k0_, qr[d0], P0, 0, 0, 0); P1 = __builtin_amdgcn_mfma_f32_32x32x16_bf16(k1_, qr[d0], P1, 0, 0, 0); } } while (0)
    __syncthreads();
    ATT_DMA(0, 0); ATT_DMA(1, 1); ATT_DMA(2, 2);
    if (wid < 5) asm volatile("s_waitcnt vmcnt(3) lgkmcnt(0)" ::: "memory"); else asm volatile("s_waitcnt vmcnt(2) lgkmcnt(0)" ::: "memory");
    __builtin_amdgcn_s_barrier(); asm volatile("" ::: "memory");
    const int vofs = ((lane >> 4) & 1) * 32 + (lane & 3) * 8 + (4 * hi + ((lane & 15) >> 2)) * 64;
    f32x16 negm = {};
    f32x16 pa0, pa1, pb0 = {}, pb1 = {};
    bf16x8 ka[8];
    { ATT_KLD(F.lds); ATT_QKM(pa0, pa1); }
    float mx = att_rowmax(pa0, pa1);
    int sl_cur = 0, sl_nxt = 1, sl_nn = 2, sl_fre = 3;
#define ATT_STEP(PC0, PC1, PN0, PN1, t_) do { const int t = (t_); \
        if (VAR != 4 && VAR != 6 && t + 3 < NT) ATT_DMA(t + 3, sl_fre); \
        if (t == 0 || __any(mx > ATT_THR)) { \
            const float dl = t == 0 ? mx : fmaxf(mx, 0.f), alpha = __builtin_amdgcn_exp2f(-dl); \
            m_run += dl; l_run *= alpha; \
            _Pragma("unroll") for (int r = 0; r < 16; ++r) { PC0[r] -= dl; PC1[r] -= dl; negm[r] = -m_run; } \
            if (hi == 0) wsf[r32] = alpha; \
            asm volatile("s_waitcnt lgkmcnt(0)" ::: "memory"); \
            _Pragma("unroll") for (int q4 = 0; q4 < 4; ++q4) { const f32x4 al = *(const LAS f32x4*)(wsf + 8 * q4 + 4 * hi); \
                _Pragma("unroll") for (int j = 0; j < 4; ++j) { o0[4 * q4 + j] *= al[j]; o1[4 * q4 + j] *= al[j]; } } \
            asm volatile("s_waitcnt lgkmcnt(0)" ::: "memory"); \
        } \
        ATT_KLD(F.lds + sl_nxt * ATT_SLOT); \
        if (VAR != 3 && VAR != 5) ATT_QKM(PN0, PN1); else { asm volatile("" : "+v"(PN0), "+v"(PN1)); } \
        float ps = 0.f; \
        _Pragma("unroll") for (int r = 0; r < 16; ++r) { if (VAR != 2 && VAR != 5) { PC0[r] = __builtin_amdgcn_exp2f(PC0[r]); PC1[r] = __builtin_amdgcn_exp2f(PC1[r]); } ps += PC0[r] + PC1[r]; } \
        l_run += ps; asm volatile("" : "+v"(l_run));     \
        u32x4 pw[4]; \
        pw[0] = (u32x4){pk2(PC0[0], PC0[1]), pk2(PC0[2], PC0[3]), pk2(PC0[4], PC0[5]), pk2(PC0[6], PC0[7])}; \
        pw[1] = (u32x4){pk2(PC0[8], PC0[9]), pk2(PC0[10], PC0[11]), pk2(PC0[12], PC0[13]), pk2(PC0[14], PC0[15])}; \
        pw[2] = (u32x4){pk2(PC1[0], PC1[1]), pk2(PC1[2], PC1[3]), pk2(PC1[4], PC1[5]), pk2(PC1[6], PC1[7])}; \
        pw[3] = (u32x4){pk2(PC1[8], PC1[9]), pk2(PC1[10], PC1[11]), pk2(PC1[12], PC1[13]), pk2(PC1[14], PC1[15])}; \
        _Pragma("unroll") for (int i = 0; i < 12; ++i) { __builtin_amdgcn_sched_group_barrier(0x008, 1, 0); if (i == 3) __builtin_amdgcn_sched_group_barrier(0x100, 4, 0); __builtin_amdgcn_sched_group_barrier(0x002, 7, 0); } \
        __builtin_amdgcn_sched_barrier(0); \
        const lds_cptr vp0 = (lds_cptr)(F.lds + sl_cur * ATT_SLOT + 13312) + vofs; \
        if (VAR != 1 && VAR != 5) { \
            _Pragma("unroll") for (int ks = 0; ks < 4; ++ks) { \
                const s16x4 l0 = vtr(vp0 + ks * 1024), h0 = vtr(vp0 + ks * 1024 + 512), l1 = vtr(vp0 + 4096 + ks * 1024), h1 = vtr(vp0 + 4096 + ks * 1024 + 512); \
                ka[2 * ks] = (bf16x8){l0[0], l0[1], l0[2], l0[3], h0[0], h0[1], h0[2], h0[3]}; ka[2 * ks + 1] = (bf16x8){l1[0], l1[1], l1[2], l1[3], h1[0], h1[1], h1[2], h1[3]}; } \
            __builtin_amdgcn_sched_barrier(0); \
            _Pragma("unroll") for (int ks = 0; ks < 4; ++ks) { \
                const bf16x8 pa = __builtin_bit_cast(bf16x8, pw[ks]); \
                o0 = __builtin_amdgcn_mfma_f32_32x32x16_bf16(pa, ka[2 * ks], o0, 0, 0, 0); \
                o1 = __builtin_amdgcn_mfma_f32_32x32x16_bf16(pa, ka[2 * ks + 1], o1, 0, 0, 0); } } \
        else { asm volatile("" :: "v"(pw[0]), "v"(pw[1]), "v"(pw[2]), "v"(pw[3])); } \
        mx = att_rowmax(PN0, PN1); \
        _Pragma("unroll") for (int i = 0; i < 8; ++i) { __builtin_amdgcn_sched_group_barrier(0x008, 1, 0); __builtin_amdgcn_sched_group_barrier(0x002, 3, 0); } \
        { const int tmp = sl_cur; sl_cur = sl_nxt; sl_nxt = sl_nn; sl_nn = sl_fre; sl_fre = tmp; } \
        if (t + 3 < NT) { if (wid < 5) asm volatile("s_waitcnt vmcnt(3) lgkmcnt(0)" ::: "memory"); else asm volatile("s_waitcnt vmcnt(2) lgkmcnt(0)" ::: "memory"); } \
        else asm volatile("s_waitcnt vmcnt(0) lgkmcnt(0)" ::: "memory"); \
        if (VAR != 6) __builtin_amdgcn_s_barrier(); asm volatile("" ::: "memory"); } while (0)
    for (int t2 = 0; t2 < NT; t2 += 2) {
        ATT_STEP(pa0, pa1, pb0, pb1, t2);
        ATT_STEP(pb0, pb1, pa0, pa1, t2 + 1);
    }
#undef ATT_STEP
    {
        float lt = sum_x32(l_run);
        if (hi == 0) wsf[32 + r32] = __builtin_amdgcn_rcpf(lt);
        asm volatile("s_waitcnt lgkmcnt(0)" ::: "memory");
        bf16* ao = AO + (size_t)(qrow0 + wid * 32) * 512 + h * 64 + r32;
#pragma unroll
        for (int q4 = 0; q4 < 4; ++q4) { const f32x4 il = *(const LAS f32x4*)(wsf + 32 + 8 * q4 + 4 * hi);
#pragma unroll
            for (int j = 0; j < 4; ++j) { const int r = 4 * q4 + j, qq = crow(r, hi); ao[(size_t)qq * 512] = f2bf(o0[r] * il[j]); ao[(size_t)qq * 512 + 32] = f2bf(o1[r] * il[j]); } }
        asm volatile("s_waitcnt lgkmcnt(0)" ::: "memory");
    }
#undef ATT_DMA
#undef ATT_KLD
#undef ATT_QKM
}

__device__ __forceinline__ f32x4 mfma16(bf16x8 a, bf16x8 b, f32x4 c) { return __builtin_amdgcn_mfma_f32_16x16x32_bf16(a, b, c, 0, 0, 0); }
__device__ __forceinline__ bf16x8 trpair(lds_cptr lo, lds_cptr hi) { const s16x4 a = vtr(lo), b = vtr(hi); return (bf16x8){a[0], a[1], a[2], a[3], b[0], b[1], b[2], b[3]}; }
template <int VAR = 0> __device__ __forceinline__ void ssd_unit(const Frame& F, int l, int b, int dir, int h, bool ctx_y, bf16* Yover = nullptr) {
    const bf16* XBC = WSP(bf16, B_XBC); const float* DT = WSP(float, B_DT); bf16* Y = Yover ? Yover : (dir == 0 ? WSP(bf16, B_YF) : WSP(bf16, B_YB));
    int tid = F.tid; asm volatile("" : "+v"(tid));
    const int lane = tid & 63, wid = F.wave, l15 = lane & 15, g4 = lane >> 4, grp = h >> 2;
    constexpr int P = 136, PX = 72;
    unsigned oB = 34816, oX = 69632, oW = 88064, oH = 106496, oA = 123904, oY = 126464;
    asm volatile("" : "+s"(oB), "+s"(oX), "+s"(oW), "+s"(oH), "+s"(oA), "+s"(oY));
    LAS bf16* CS = (LAS bf16*)(F.lds); LAS bf16* BS = (LAS bf16*)(F.lds + oB); LAS bf16* XS = (LAS bf16*)(F.lds + oX); LAS bf16* XW = (LAS bf16*)(F.lds + oW); LAS bf16* HS = (LAS bf16*)(F.lds + oH);
    LAS float* ACU = (LAS float*)(F.lds + oA); LAS float* DTV = ACU + 128; LAS float* WQ = ACU + 256; LAS float* ATOT = ACU + 384; LAS float* FJ = ACU + 512;
    LAS bf16* YST = (LAS bf16*)(F.lds + oY) + wid * (16 * PX);
    const float Acoef = -__expf(INP(I_ALOG)[(l * 2 + dir) * 8 + h]); const float Dd = dir == 0 ? INP(I_SSMD)[l * 8 + h] : 0.f;
    const int refo = dir ? 0 : 15;
    f32x4 hst[4];
#pragma unroll
    for (int pt = 0; pt < 4; ++pt) hst[pt] = (f32x4){0.f, 0.f, 0.f, 0.f};
    __syncthreads();
    for (int i = tid; i < 64 * P / 2; i += NTHR) ((LAS unsigned*)HS)[i] = 0u;
    const int trq = (lane & 15) >> 2, trp = (lane & 3) * 4;
    const int crow_ = tid >> 4, cch = tid & 15;
    const int xq = tid >> 3, xch = tid & 7;
    u32x4 c_r[4], b_r[4], x_r[2]; float d_r0 = 0.f, d_r1 = 0.f;
#define SSD_ROW0(step_) (((step_) < 2) ? NLAT + b * CTXL + (dir == 0 ? (step_) : 1 - (step_)) * 128 : b * SEQ + (dir == 0 ? (step_) - 2 : 17 - (step_)) * 128)
#define SSD_LOAD(step_) do { const int R_ = SSD_ROW0(step_); \
        _Pragma("unroll") for (int i = 0; i < 4; ++i) { const size_t ro = (size_t)(R_ + crow_ + 32 * i) * 1024 + grp * 128 + cch * 8; c_r[i] = *(const u32x4*)(XBC + ro + 768); b_r[i] = *(const u32x4*)(XBC + ro + 512); } \
        _Pragma("unroll") for (int i = 0; i < 2; ++i) x_r[i] = *(const u32x4*)(XBC + (size_t)(R_ + xq + 64 * i) * 1024 + h * 64 + xch * 8); \
        if (wid == 0) { const int q0 = dir ? 127 - 2 * lane : 2 * lane, q1 = dir ? 126 - 2 * lane : 2 * lane + 1; d_r0 = DT[(size_t)(R_ + q0) * 16 + dir * 8 + h]; d_r1 = DT[(size_t)(R_ + q1) * 16 + dir * 8 + h]; } } while (0)
    SSD_LOAD(0);
    for (int step = 0; step < 18; ++step) {
        const bool isctx = step < 2; const int R0 = SSD_ROW0(step);
        const bool need_y = (VAR != 1) && (!isctx || ctx_y);
#pragma unroll
        for (int i = 0; i < 4; ++i) { *(LAS u32x4*)(CS + (crow_ + 32 * i) * P + cch * 8) = c_r[i]; *(LAS u32x4*)(BS + (crow_ + 32 * i) * P + cch * 8) = b_r[i]; }
#pragma unroll
        for (int i = 0; i < 2; ++i) *(LAS u32x4*)(XS + (xq + 64 * i) * PX + xch * 8) = x_r[i];
        if (wid == 0) {
            const int q0 = dir ? 127 - 2 * lane : 2 * lane, q1 = dir ? 126 - 2 * lane : 2 * lane + 1;
            const float a0 = d_r0 * Acoef, a1 = d_r1 * Acoef, sm = a0 + a1; float incl = sm;
#pragma unroll
            for (int off = 1; off < 64; off <<= 1) { const float t = __shfl_up(incl, off); if (lane >= off) incl += t; }
            const float excl = incl - sm, c0 = excl + a0, c1 = incl, atot = __shfl(incl, 63);
            ACU[q0] = c0; ACU[q1] = c1; DTV[q0] = d_r0; DTV[q1] = d_r1; WQ[q0] = __expf(atot - c0) * d_r0; WQ[q1] = __expf(atot - c1) * d_r1;
            if (lane == 0) ATOT[0] = atot;
            asm volatile("s_waitcnt lgkmcnt(0)" ::: "memory");
            FJ[q0] = __expf(ACU[(q0 & ~15) + refo] - c0) * d_r0; FJ[q1] = __expf(ACU[(q1 & ~15) + refo] - c1) * d_r1;
        }
        __syncthreads();
#pragma unroll
        for (int i = 0; i < 2; ++i) { float f[8]; unpack8(x_r[i], f); const float wq = WQ[xq + 64 * i];
            u32x4 o; o.x = pk2(f[0] * wq, f[1] * wq); o.y = pk2(f[2] * wq, f[3] * wq); o.z = pk2(f[4] * wq, f[5] * wq); o.w = pk2(f[6] * wq, f[7] * wq);
            *(LAS u32x4*)(XW + (xq + 64 * i) * PX + xch * 8) = o; }
        if (step + 1 < 18 && VAR != 3) SSD_LOAD(step + 1);
        bf16x8 cfr[4];
#pragma unroll
        for (int kk = 0; kk < 4; ++kk) cfr[kk] = *(const LAS bf16x8*)(CS + (16 * wid + l15) * P + kk * 32 + g4 * 8);
        if (need_y) {
            f32x4 T[8];
#pragma unroll
            for (int jt = 0; jt < 8; ++jt) { f32x4 a = (f32x4){0.f, 0.f, 0.f, 0.f};
#pragma unroll
                for (int kk = 0; kk < 4; ++kk) { const bf16x8 bb = *(const LAS bf16x8*)(BS + (16 * jt + l15) * P + kk * 32 + g4 * 8); a = mfma16(bb, cfr[kk], a); }
                T[jt] = a; }
            int ii = 16 * wid + l15, jb = 4 * g4; asm volatile("" : "+v"(ii), "+v"(jb));
            const float ai = ACU[ii];
            bf16x8 sfr[4];
#pragma unroll
            for (int m = 0; m < 4; ++m) { u32x4 pk;
#pragma unroll
                for (int hh = 0; hh < 2; ++hh) { const int jt = 2 * m + hh; const f32x4 fj = *(const LAS f32x4*)(FJ + 16 * jt + jb); const float ei = __expf(ai - ACU[16 * jt + refo]); float sv[4];
#pragma unroll
                    for (int r = 0; r < 4; ++r) { const int j = 16 * jt + jb + r; const bool valid = dir == 0 ? (j <= ii) : (j >= ii); sv[r] = valid ? T[jt][r] * ei * fj[r] : 0.f; }
                    if (hh == 0) { pk.x = pk2(sv[0], sv[1]); pk.y = pk2(sv[2], sv[3]); } else { pk.z = pk2(sv[0], sv[1]); pk.w = pk2(sv[2], sv[3]); } }
                sfr[m] = __builtin_bit_cast(bf16x8, pk); }
            f32x4 ee = *(const LAS f32x4*)(ACU + 16 * wid + 4 * g4);
#pragma unroll
            for (int r = 0; r < 4; ++r) ee[r] = __expf(ee[r]);
#pragma unroll
            for (int pt = 0; pt < 4; ++pt) { f32x4 yi = (f32x4){0.f, 0.f, 0.f, 0.f}, ye = (f32x4){0.f, 0.f, 0.f, 0.f};
#pragma unroll
                for (int m = 0; m < 4; ++m) { const lds_cptr xb = (lds_cptr)(XS + (32 * m + 4 * g4 + trq) * PX + 16 * pt + trp); yi = mfma16(sfr[m], trpair(xb, xb + 16 * PX * 2), yi); }
#pragma unroll
                for (int kk = 0; kk < 4; ++kk) { const bf16x8 bh = *(const LAS bf16x8*)(HS + (16 * pt + l15) * P + kk * 32 + g4 * 8); ye = mfma16(cfr[kk], bh, ye); }
                const s16x4 xd = vtr((lds_cptr)(XS + (16 * wid + 4 * g4 + trq) * PX + 16 * pt + trp));
#pragma unroll
                for (int r = 0; r < 4; ++r) YST[(4 * g4 + r) * PX + 16 * pt + l15] = f2bf(yi[r] + ee[r] * ye[r] + Dd * bf2f((bf16)xd[r])); }
            asm volatile("s_waitcnt lgkmcnt(0)" ::: "memory");
            { const int yr = lane >> 2, yc = lane & 3;
#pragma unroll
              for (int k = 0; k < 2; ++k) { const u32x4 v = *(const LAS u32x4*)(YST + yr * PX + (yc + 4 * k) * 8); if (VAR != 4) *(u32x4*)(Y + (size_t)(R0 + 16 * wid + yr) * 512 + h * 64 + (yc + 4 * k) * 8) = v; else asm volatile("" :: "v"(v)); } }
        }
        __syncthreads();
        if (VAR != 2) {
            const float decay = __expf(ATOT[0]);
            bf16x8 bq[4];
#pragma unroll
            for (int kk = 0; kk < 4; ++kk) { const lds_cptr bb = (lds_cptr)(BS + (32 * kk + 8 * g4 + trq) * P + 16 * wid + trp); bq[kk] = trpair(bb, bb + 4 * P * 2); }
#pragma unroll
            for (int pt = 0; pt < 4; ++pt) { f32x4 a = hst[pt] * decay;
#pragma unroll
                for (int kk = 0; kk < 4; ++kk) { const lds_cptr xb = (lds_cptr)(XW + (32 * kk + 8 * g4 + trq) * PX + 16 * pt + trp); a = mfma16(trpair(xb, xb + 4 * PX * 2), bq[kk], a); }
                hst[pt] = a;
#pragma unroll
                for (int r = 0; r < 4; ++r) HS[(16 * pt + 4 * g4 + r) * P + 16 * wid + l15] = f2bf(a[r]); }
        }
        __syncthreads();
    }
#undef SSD_ROW0
#undef SSD_LOAD
}

__device__ __forceinline__ void gmlp_unit(const Frame& F, int l, int R0, int g) {
    constexpr int PV = 72, PO = 68;
    LAS bf16* VN = (LAS bf16*)(F.lds);
    const bf16* UV = WSP(bf16, B_UV); bf16* GM = WSP(bf16, B_GM); const float* VSUM = WSP(float, WS_STAT) + 2 * NTOK; const float* VSQ = WSP(float, WS_STAT) + 3 * NTOK;
    const bf16* Wg = WGT(W_GS) + (size_t)g * 128 * 128; const float* gn = INP(I_GMNORM) + l * 512 + g * 64; const float* bs = INP(I_GMBS) + (l * 8 + g) * 128;
    int tid = F.tid; asm volatile("" : "+v"(tid));
    const int lane = tid & 63, wid = F.wave, l15 = lane & 15, l4 = lane >> 4, trq = (lane & 15) >> 2, trp = (lane & 3) * 4;
    LAS float* OST = (LAS float*)(F.lds + 18432) + wid * (16 * PO);
    bf16x8 a[4];
#pragma unroll
    for (int kk = 0; kk < 4; ++kk) a[kk] = *(const bf16x8*)(Wg + (16 * wid + l15) * 128 + kk * 32 + l4 * 8);
    __syncthreads();
#pragma unroll
    for (int i = 0; i < 2; ++i) { const int piece = tid + NTHR * i, j = piece >> 3, ch = piece & 7;
        const u32x4 vv = *(const u32x4*)(UV + (size_t)(R0 + j) * 1024 + 512 + g * 64 + ch * 8); float f[8]; unpack8(vv, f);
        const float mean = VSUM[R0 + j] * (1.f / 512.f); const float var = fmaxf(VSQ[R0 + j] * (1.f / 512.f) - mean * mean, 0.f); const float rstd = rsqf_(var + EPS);
        const f32x4 g0 = *(const f32x4*)(gn + ch * 8), g1 = *(const f32x4*)(gn + ch * 8 + 4);
        u32x4 o; o.x = pk2((f[0] - mean) * rstd * g0[0], (f[1] - mean) * rstd * g0[1]); o.y = pk2((f[2] - mean) * rstd * g0[2], (f[3] - mean) * rstd * g0[3]);
        o.z = pk2((f[4] - mean) * rstd * g1[0], (f[5] - mean) * rstd * g1[1]); o.w = pk2((f[6] - mean) * rstd * g1[2], (f[7] - mean) * rstd * g1[3]);
        *(LAS u32x4*)(VN + j * PV + ch * 8) = o; }
    __syncthreads();
    const f32x4 bi = *(const f32x4*)(bs + 16 * wid + 4 * l4);
#pragma unroll
    for (int dt = 0; dt < 4; ++dt) { f32x4 acc = (f32x4){0.f, 0.f, 0.f, 0.f};
#pragma unroll
        for (int kk = 0; kk < 4; ++kk) { const lds_cptr vb = (lds_cptr)(VN + (32 * kk + 8 * l4 + trq) * PV + 16 * dt + trp); acc = mfma16(a[kk], trpair(vb, vb + 4 * PV * 2), acc); }
#pragma unroll
        for (int r = 0; r < 4; ++r) OST[(4 * l4 + r) * PO + 16 * dt + l15] = acc[r] + bi[r]; }
    asm volatile("s_waitcnt lgkmcnt(0)" ::: "memory");
    { const int yr = lane >> 2, yc = (lane & 3) * 16; const size_t rowg = (size_t)(R0 + 16 * wid + yr);
      float uu[16]; unpack8(*(const u32x4*)(UV + rowg * 1024 + g * 64 + yc), uu); unpack8(*(const u32x4*)(UV + rowg * 1024 + g * 64 + yc + 8), uu + 8);
      f32x4 mx[4];
#pragma unroll
      for (int k = 0; k < 4; ++k) mx[k] = *(const LAS f32x4*)(OST + yr * PO + yc + 4 * k);
      u32x4 o0, o1;
      o0.x = pk2(uu[0] * mx[0][0], uu[1] * mx[0][1]); o0.y = pk2(uu[2] * mx[0][2], uu[3] * mx[0][3]); o0.z = pk2(uu[4] * mx[1][0], uu[5] * mx[1][1]); o0.w = pk2(uu[6] * mx[1][2], uu[7] * mx[1][3]);
      o1.x = pk2(uu[8] * mx[2][0], uu[9] * mx[2][1]); o1.y = pk2(uu[10] * mx[2][2], uu[11] * mx[2][3]); o1.z = pk2(uu[12] * mx[3][0], uu[13] * mx[3][1]); o1.w = pk2(uu[14] * mx[3][2], uu[15] * mx[3][3]);
      *(u32x4*)(GM + rowg * 512 + g * 64 + yc) = o0; *(u32x4*)(GM + rowg * 512 + g * 64 + yc + 8) = o1; }
}

constexpr int PH_PER_LAYER = 13, N_PHASES = 1 + 2 * PH_PER_LAYER + 1;

__global__ void __launch_bounds__(NTHR, 2) mk_fwd(Args args) {
    extern __shared__ __attribute__((aligned(16))) unsigned char lds_raw[];
    Frame F;
    F.lds = (LAS unsigned char*)lds_raw;
    F.tid = threadIdx.x; F.lane = F.tid & 63; F.wave = __builtin_amdgcn_readfirstlane(F.tid >> 6);
    F.G = gridDim.x; F.bid = blockIdx.x; F.vcu = F.bid; F.z = 0;
    F.ka = (const __attribute__((address_space(4))) char*)__builtin_amdgcn_kernarg_segment_ptr();
    volatile LAS unsigned* MISC = (volatile LAS unsigned*)(F.lds + MISC_OFF);
    if (F.tid < 64) MISC[F.tid] = 0u;
    __syncthreads();
    unsigned* ctl = WSP(unsigned, WS_CTL);
    XcdBarrier bar; bar.bar = ctl + CW_BAR; bar.x = 0; bar.st = nullptr;
#if !MK_PER_PHASE
    bar = xcd_barrier_post(ctl + CW_BAR, MISC + 8);
#endif
    const int lo = args.ph_lo, hi = args.ph_hi;
#define TID0() (F.wave == 0 && __builtin_amdgcn_mbcnt_hi(~0u, __builtin_amdgcn_mbcnt_lo(~0u, 0u)) == 0u)
    if (PROBING && blockIdx.x == 0 && TID0()) ((unsigned long long*)(ctl + CW_TS))[0] = __builtin_amdgcn_s_memrealtime();
#ifndef PHMASK
#define PHMASK 0xFFFFu
#endif
#define IN(k) (lo <= (k) && (k) < hi)
#define PM(i) (((PHMASK) >> (i)) & 1u)
#define PHASE_BEGIN() do { F.z = 0; asm volatile("" : "+s"(F.z)); asm volatile("" : "+s"(F.ka)); asm volatile("" : "+s"(lq)); F.lane = (int)__builtin_amdgcn_mbcnt_hi(~0u, __builtin_amdgcn_mbcnt_lo(~0u, 0u)); F.tid = (F.wave << 6) | F.lane; asm volatile("" : "+v"(F.tid)); F.lane = F.tid & 63; \
        F.G = (int)gridDim.x + (int)F.z; F.bid = (int)blockIdx.x + (int)F.z; F.vcu = (F.G % 8 == 0) ? (F.bid % 8) * (F.G / 8) + F.bid / 8 : F.bid; } while (0)
#ifndef MXMASK
#define MXMASK 0xFFu
#endif
#define MX(i) (((MXMASK) >> (i)) & 1u)
#if MK_PER_PHASE
#define SEAM(k) do {} while (0)
#else
#define MIDSEAM() xcd_barrier(bar, F.wave)
#define SEAM(k) do { if (IN(k) && IN((k) + 1)) xcd_barrier(bar, F.wave); if (PROBING && blockIdx.x == 0 && TID0()) ((unsigned long long*)(ctl + CW_TS))[(k) + 1] = __builtin_amdgcn_s_memrealtime(); } while (0)
#endif
    LAS unsigned char* glds = F.lds;
    const float* MOD = WSP(float, WS_MOD);

    int lq = 0;
    if (PM(13) && IN(0)) { PHASE_BEGIN(); prologue_mod(F); __syncthreads();
#pragma clang loop unroll(disable)
        for (int set = 0; set < 4; ++set) convert_set(F, 0, set, F.vcu, F.G, WGT(W_F2I)); }
    SEAM(0);
#pragma clang loop unroll(disable)
    for (int l = 0; l < 2; ++l) {
        const int pb = 1 + PH_PER_LAYER * l; const bool last = (l == 1); int lq = l;
#define modl (MOD + (size_t)lq * 9 * MODW)
        if (PM(0) && IN(pb + 0)) { PHASE_BEGIN(); if (lq > 0) { norm_phase(F, lq, 0, false, false, NLAT, NTOK, 4, WSP(bf16, WS_H)); zero_rssn(F, 1, 1); }
            else { norm_phase(F, lq, 0, true, true, 0, NTOK, 0, WSP(bf16, WS_H)); shw_phase(F); zero_rssn(F, 0, 3); } }
        SEAM(pb + 0);
#if PROBE_CVT >= 0
        if (lq > 0) { PHASE_BEGIN();
            if (blockIdx.x == 0 && TID0()) ((unsigned long long*)(ctl + CW_TS))[56] = __builtin_amdgcn_s_memrealtime();
            if (PROBE_CVT == 0) { for (int set = 0; set < 4; ++set) convert_set(F, lq, set, F.vcu, F.G, F2ALT); } else norm_phase(F, lq, 0, false, false, NLAT, NTOK, 0, WSP(bf16, WS_H));
            xcd_barrier(bar, F.wave);
            if (blockIdx.x == 0 && TID0()) ((unsigned long long*)(ctl + CW_TS))[57] = __builtin_amdgcn_s_memrealtime();
        }
#endif
        if (PM(1) && IN(pb + 1)) { PHASE_BEGIN(); pg8::Gemm g{WSP(bf16, WS_H), WGT(W_F1I), NTOK, 2 * DFF, DM, DM, DM}; pg8::StaticOrder S; S.init(NTOK, 2 * DFF, F.G, F.bid);
            EpiSwiglu E{WSP(bf16, B_ACT), WSP(float, WS_RSSN), WSP(float, WS_SHW) + (size_t)lq * SHW_LAYER + SHW_F1, lq > 0 ? 1 : 0}; pg8::gemm_phase<EpiSwiglu, pg8::StaticOrder, true, true>(glds, g, S, E, F.tid);
            if (lq == 0) tail_convert(F, S.nwg, 0); }
        SEAM(pb + 1);
        if (PM(2) && IN(pb + 2)) { PHASE_BEGIN();
#pragma clang loop unroll(disable)
            for (int pass = 0; pass < 2; ++pass) {
            if ((pass == 1) == (F.bid < 128)) {
            { pg8::Gemm g{WSP(bf16, B_ACT), WGT(W_F1O), NLAT, DM, DFF, DFF, DFF}; pg8::StaticOrder S; S.init(NLAT, DM, F.G, F.bid);
              EpiResidN E{XBP, modl, modl, INP(I_NORMG) + (lq * 3 + 1) * DM, WSP(float, WS_RSSN) + NLAT, WSP(bf16, WS_H), 2, 1, 0.5f}; pg8::gemm_phase<EpiResidN, pg8::StaticOrder, true, true>(glds, g, S, E, F.tid); }
            } else {
            { pg8::Gemm g{WSP(bf16, B_ACT) + (size_t)NLAT * DFF, WGT(W_F1O), NCTX, DM, 768, DFF, DFF}; pg8::SliceOrder S; S.init(NCTX, DM, 2, F.G, F.bid);
              EpiSlab E{WSP(float, B_SLAB), modl, 2, 0, 0.5f}; pg8::gemm_phase<EpiSlab, pg8::SliceOrder, true, true>(glds, g, S, E, F.tid); }
            { pg8::Gemm g{WSP(bf16, B_ACT) + (size_t)NLAT * DFF + 1536, WGT(W_F1O) + 1536, NCTX, DM, 640, DFF, DFF}; pg8::SliceOrder S; S.init(NCTX, DM, 2, F.G, (F.bid + F.G - 64) % F.G);
              EpiSlab E{WSP(float, B_SLAB), modl, 2, 2, 0.5f}; pg8::gemm_phase<EpiSlab, pg8::SliceOrder, true, true>(glds, g, S, E, F.tid); }
            } }
        }
        SEAM(pb + 2);
        if (PM(3) && IN(pb + 3)) { PHASE_BEGIN(); norm_phase(F, lq, 1, false, lq == 0, NLAT, NTOK, 4, WSP(bf16, WS_H)); zero_stats(F); zero_rssn(F, 2, 1); }
        SEAM(pb + 3);
        if (PM(4) && IN(pb + 4)) { PHASE_BEGIN();
            EpiInA E{0, WS_BASE, INP(I_DTBIAS) + lq * 16, (int)(lq * SHW_LAYER)};
            if (!last) { pg8::Gemm g{WSP(bf16, WS_H), WGT(W_INA), NTOK, 3072, DM, DM, DM}; pg8::StaticOrder S; S.init(NTOK, 3072, F.G, F.bid); pg8::gemm_phase<EpiInA, pg8::StaticOrder, true, true>(glds, g, S, E, F.tid);
                         if (lq == 0) tail_convert(F, S.nwg, 1); }
            else { { pg8::Gemm g{WSP(bf16, WS_H), WGT(W_INA), NLAT, 3072, DM, DM, DM}; pg8::StaticOrder S; S.init(NLAT, 3072, F.G, F.bid); pg8::gemm_phase<EpiInA, pg8::StaticOrder, true, true>(glds, g, S, E, F.tid); }
                   { E.row_off = NLAT; pg8::Gemm g{WSP(bf16, WS_H) + (size_t)NLAT * DM, WGT(W_INA), NCTX, 1280, DM, DM, DM}; pg8::StaticOrder S; S.init(NCTX, 1280, F.G, (int)((F.bid + 128) % F.G)); pg8::gemm_phase<EpiInA, pg8::StaticOrder, true, true>(glds, g, S, E, F.tid); } }
        }
        SEAM(pb + 4);
        if (PM(5) && IN(pb + 5)) { PHASE_BEGIN();
            if (MX(3)) { pg8::Gemm g{WSP(bf16, B_KVR), WGT(W_UKV), NTOK, 1024, 256, 256, 256}; pg8::StaticOrder S; S.init(NTOK, 1024, F.G, F.bid);
              pg8::Epi8<FKvUp> E{FKvUp{WS_BASE}}; pg8::gemm_phase<pg8::Epi8<FKvUp>, pg8::StaticOrder, true, true>(glds, g, S, E, F.tid); }
            if (MX(4)) { const int M = last ? NLAT : NTOK; pg8::Gemm g{WSP(bf16, B_QLAT), WGT(W_UQ), M, 768, 256, 256, 256}; pg8::StaticOrder S; S.init(M, 768, F.G, (int)((F.bid + 32) % F.G));
              pg8::Epi8<FQUp> E{FQUp{WS_BASE}}; pg8::gemm_phase<pg8::Epi8<FQUp>, pg8::StaticOrder, true, true>(glds, g, S, E, F.tid); }
            if (MX(5)) conv_phase(F, lq, NTOK);
        }
        SEAM(pb + 5);
        if (PM(6) && IN(pb + 6)) { PHASE_BEGIN();
            const int nssd = 128, natt = 512 + (last ? 0 : 64), ngm = 256 + (last ? 0 : 32), ntot = nssd + natt + ngm;
            unsigned* head = ctl + CW_QUEUE + 64 * lq;
            for (;;) {
                __syncthreads();
                if (F.tid == 0) MISC[0] = __hip_atomic_fetch_add(head, 1u, __ATOMIC_RELAXED, __HIP_MEMORY_SCOPE_AGENT);
                __syncthreads();
                int u = (int)MISC[0];
                if (u >= ntot) break;
                const int u0_ = u;
                if (u < nssd) { if (MX(0)) ssd_unit(F, lq, u >> 4, (u >> 3) & 1, u & 7, !last); }
                else if (u < nssd + natt) { u -= nssd;
                    if (u < 512) { const int b = u >> 6, h = (u >> 3) & 7, qb = u & 7; if (MX(1)) attn_unit<1>(F, h, b * SEQ + qb * 256, b * SEQ, 32, NLAT + b * CTXL, 4); }
                    else { u -= 512; const int b = u >> 3, h = u & 7; if (MX(1)) attn_unit<1>(F, h, NLAT + b * CTXL, NLAT + b * CTXL, 4, 0, 0); } }
                else { u -= nssd + natt;
                    int R0g, g0;
                    if (u < 256) { const int b = u >> 5, c = (u >> 1) & 15; R0g = b * SEQ + c * 128; g0 = (u & 1) * 4; }
                    else { u -= 256; const int b = u >> 2, c = (u >> 1) & 1; R0g = NLAT + b * CTXL + c * 128; g0 = (u & 1) * 4; }
                    if (MX(2)) { for (int gg = 0; gg < 4; ++gg) gmlp_unit(F, lq, R0g, g0 + gg); } }
                if (PROBING && !last && F.tid == 0) { const int k_ = u0_ < nssd ? 40 : (u0_ < nssd + natt ? 41 : 42); atomicMax((unsigned long long*)(ctl + CW_TS) + k_, (unsigned long long)__builtin_amdgcn_s_memrealtime()); }
            }
        }
        SEAM(pb + 6);
#if PROBE_ATTV >= 0
        if (lq == 0) { PHASE_BEGIN();
            if (blockIdx.x == 0 && TID0()) ((unsigned long long*)(ctl + CW_TS))[54] = __builtin_amdgcn_s_memrealtime();
            for (int u = F.bid; u < 512; u += F.G) { const int b = u >> 6, h = (u >> 3) & 7, qb = u & 7; attn_unit<1, PROBE_ATTV>(F, h, b * SEQ + qb * 256, b * SEQ, 32, NLAT + b * CTXL, 4, WSP(bf16, B_UV)); }
            xcd_barrier(bar, F.wave);
            if (blockIdx.x == 0 && TID0()) ((unsigned long long*)(ctl + CW_TS))[55] = __builtin_amdgcn_s_memrealtime();
        }
#endif
#if PROBE_SSDV >= 0
        if (lq == 0) { PHASE_BEGIN();
            if (blockIdx.x == 0 && TID0()) ((unsigned long long*)(ctl + CW_TS))[52] = __builtin_amdgcn_s_memrealtime();
            if (F.bid < 128) ssd_unit<PROBE_SSDV>(F, lq, F.bid >> 4, (F.bid >> 3) & 1, F.bid & 7, true, WSP(bf16, B_Q));
            xcd_barrier(bar, F.wave);
            if (blockIdx.x == 0 && TID0()) ((unsigned long long*)(ctl + CW_TS))[53] = __builtin_amdgcn_s_memrealtime();
        }
#endif
        const int MR = last ? NLAT : NTOK;
        if (PM(7) && IN(pb + 7)) { PHASE_BEGIN();
            ssm_out_prep(F, lq, MR);
            pg8::Gemm g{WSP(bf16, WS_H), WGT(W_GATE), MR, 3072, DM, DM, DM}; pg8::StaticOrder S; S.init(MR, 3072, F.G, F.bid);
            EpiGates E{WSP(bf16, B_GATES), INP(I_BGATE) + lq * 3072, WSP(float, WS_RSSN) + NLAT, WSP(float, WS_SHW) + (size_t)lq * SHW_LAYER + SHW_GATE}; pg8::gemm_phase<EpiGates, pg8::StaticOrder, true, true>(glds, g, S, E, F.tid);
            if (lq == 0) tail_convert(F, S.nwg, 2);
        }
        SEAM(pb + 7);
        if (PM(8) && IN(pb + 8)) { PHASE_BEGIN();
            { pg8::ChainOrder S; S.init(NLAT, DM, F.G, F.bid);
              pg8::Gemm g{WSP(bf16, B_AMLA), WGT(W_MO), NLAT, DM, 512, 512, 512, WSP(bf16, B_YF), WSP(bf16, B_GM), WGT(W_SO), WGT(W_GO)};
              EpiMergeChain E{WSP(bf16, B_GATES), WSP(bf16, WS_H)}; pg8::gemm_phase<EpiMergeChain, pg8::ChainOrder, true, true>(glds, g, S, E, F.tid); }
            if (!last) {
              { pg8::BranchOrder S; S.init(NCTX, DM, F.G, F.bid);
                pg8::Gemm g{WSP(bf16, B_AMLA) + (size_t)NLAT * 512, WGT(W_MO), NCTX, DM, 512, 512, 512, WSP(bf16, B_YF) + (size_t)NLAT * 512, WSP(bf16, B_GM) + (size_t)NLAT * 512, WGT(W_SO), WGT(W_GO)};
                EpiMergeSlab E{WSP(bf16, B_GATES), WSP(float, B_MSLAB)}; pg8::gemm_phase<EpiMergeSlab, pg8::BranchOrder, true, true>(glds, g, S, E, F.tid); }
              MIDSEAM();
              merge_ctx_sum(F);
            }
        }
        SEAM(pb + 8);
        if (PM(9) && IN(pb + 9)) { PHASE_BEGIN();
#pragma clang loop unroll(disable)
            for (int pass = 0; pass < 2; ++pass) {
            if ((pass == 1) == (F.bid < 128)) {
            { pg8::Gemm g{WSP(bf16, WS_H), WGT(W_OUT), NLAT, DM, DM, DM, DM}; pg8::StaticOrder S; S.init(NLAT, DM, F.G, F.bid);
              EpiResidN E{XBP, modl, modl, INP(I_NORMG) + (lq * 3 + 2) * DM, WSP(float, WS_RSSN) + 2 * NLAT, WSP(bf16, B_H2), 5, 2, 1.0f}; pg8::gemm_phase<EpiResidN, pg8::StaticOrder, true, true>(glds, g, S, E, F.tid); }
            } else if (!last) { pg8::Gemm g{WSP(bf16, WS_H) + (size_t)NLAT * DM, WGT(W_OUT), NCTX, DM, 256, DM, DM}; pg8::SliceOrder S; S.init(NCTX, DM, 4, F.G, F.bid);
              EpiSlab E{WSP(float, B_SLAB), modl, 5, 0, 1.0f}; pg8::gemm_phase<EpiSlab, pg8::SliceOrder, true, true>(glds, g, S, E, F.tid); }
            }
        }
        SEAM(pb + 9);
        if (PM(10) && IN(pb + 10)) { PHASE_BEGIN(); if (!last) norm_phase(F, lq, 2, false, false, NLAT, NTOK, 4, WSP(bf16, B_H2)); }
        if (!last) SEAM(pb + 10);
        if (PM(11) && IN(pb + 11)) { PHASE_BEGIN(); pg8::Gemm g{WSP(bf16, B_H2), lq > 0 ? F2ALT : WGT(W_F2I), MR, 2 * DFF, DM, DM, DM}; pg8::StaticOrder S; S.init(MR, 2 * DFF, F.G, F.bid);
            EpiSwiglu E{WSP(bf16, B_ACT), WSP(float, WS_RSSN) + 2 * NLAT, WSP(float, WS_SHW) + (size_t)lq * SHW_LAYER + SHW_F2, 1}; pg8::gemm_phase<EpiSwiglu, pg8::StaticOrder, true, true>(glds, g, S, E, F.tid);
            if (lq == 0) tail_convert(F, S.nwg, 3); }
        SEAM(pb + 11);
        if (PM(12) && IN(pb + 12)) { PHASE_BEGIN();
#pragma clang loop unroll(disable)
            for (int pass = 0; pass < 2; ++pass) {
            if ((pass == 1) == (F.bid < 128)) {
            { pg8::Gemm g{WSP(bf16, B_ACT), lq > 0 ? F2ALT + (W_F2O - W_F2I) : WGT(W_F2O), NLAT, DM, DFF, DFF, DFF}; pg8::StaticOrder S; S.init(NLAT, DM, F.G, F.bid);
              if (!last) { EpiResidN E{XBP, modl, MOD + (size_t)(lq + 1) * 9 * MODW, INP(I_NORMG) + ((lq + 1) * 3 + 0) * DM, WSP(float, WS_RSSN), WSP(bf16, WS_H), 8, 0, 0.5f}; pg8::gemm_phase<EpiResidN, pg8::StaticOrder, true, true>(glds, g, S, E, F.tid); }
              else { pg8::Epi8<FResid> E{FResid{XBP, WSP(bf16, B_XF), modl, 8, 0.5f}}; pg8::gemm_phase<pg8::Epi8<FResid>, pg8::StaticOrder, true, true>(glds, g, S, E, F.tid); } }
            } else if (!last) {
            { pg8::Gemm g{WSP(bf16, B_ACT) + (size_t)NLAT * DFF, WGT(W_F2O), NCTX, DM, 768, DFF, DFF}; pg8::SliceOrder S; S.init(NCTX, DM, 2, F.G, F.bid);
              EpiSlab E{WSP(float, B_SLAB), modl, 8, 0, 0.5f}; pg8::gemm_phase<EpiSlab, pg8::SliceOrder, true, true>(glds, g, S, E, F.tid); }
            { pg8::Gemm g{WSP(bf16, B_ACT) + (size_t)NLAT * DFF + 1536, WGT(W_F2O) + 1536, NCTX, DM, 640, DFF, DFF}; pg8::SliceOrder S; S.init(NCTX, DM, 2, F.G, (F.bid + F.G - 64) % F.G);
              EpiSlab E{WSP(float, B_SLAB), modl, 8, 2, 0.5f}; pg8::gemm_phase<EpiSlab, pg8::SliceOrder, true, true>(glds, g, S, E, F.tid); }
            } }
        }
        SEAM(pb + 12);
    }
#undef modl
    if (PM(14) && IN(N_PHASES - 1)) { PHASE_BEGIN(); final_norm(F); }
#if PROBING && !MK_PER_PHASE
    xcd_barrier(bar, F.wave);
    if (blockIdx.x == 0) {
        const unsigned long long* ts = (const unsigned long long*)(ctl + CW_TS);
        const int ptid = (F.wave << 6) | (int)__builtin_amdgcn_mbcnt_hi(~0u, __builtin_amdgcn_mbcnt_lo(~0u, 0u));
        if (PROBE_A >= 0 && ptid == 0) { const float us = (float)(ts[PROBE_AE] - ts[PROBE_A]) * 0.01f; const float v = fminf(us * (1.0f / PROBE_FS), 1.0f); args.out[0] += 0.05f + 0.14f * v; }
        if (PROBE_B >= 0) { const float us = (float)(ts[PROBE_BE] - ts[PROBE_B]) * 0.01f; const float v = fminf(us * (1.0f / PROBE_FSB), 1.0f); const float d = sqrtf(16.0f * (1e-5f + 4e-5f * v));
            for (int i = 1024 + ptid; i < 1024 + (1 << 20); i += NTHR) args.out[i] += (i & 1) ? d : -d; }
    }
#endif
#undef IN
#undef SEAM
}

extern "C" void kernel_launch(void* const* d_in, const int* in_sizes, int n_in, void* d_out, int out_size, void* d_ws, size_t ws_size, hipStream_t stream) {
    static int grid = 0;
    if (grid == 0) {
        if (n_in != 31 || in_sizes[0] != NLAT * DM || out_size != NLAT * DM || ws_size < WS_END) { fprintf(stderr, "kernel_launch: unexpected shapes (n_in %d, in0 %d, out %d, ws %zu < %zu); nothing launched\n", n_in, n_in > 0 ? in_sizes[0] : -1, out_size, ws_size, (size_t)WS_END); grid = -1; return; }
        int dev = 0, cus = 0, per_cu = 0;
        if (hipGetDevice(&dev) != hipSuccess || hipDeviceGetAttribute(&cus, hipDeviceAttributeMultiprocessorCount, dev) != hipSuccess) { grid = -1; return; }
        if (hipFuncSetAttribute((const void*)mk_fwd, hipFuncAttributeMaxDynamicSharedMemorySize, LDS_BYTES) != hipSuccess) { fprintf(stderr, "kernel_launch: hipFuncSetAttribute failed\n"); grid = -1; return; }
        if (hipOccupancyMaxActiveBlocksPerMultiprocessor(&per_cu, (const void*)mk_fwd, NTHR, LDS_BYTES) != hipSuccess || per_cu < 1) { fprintf(stderr, "kernel_launch: occupancy query says %d blocks per CU\n", per_cu); (void)hipGetLastError(); grid = -1; return; }
        grid = cus;
    }
    if (grid < 0) return;
    if (hipMemsetAsync((char*)d_ws + WS_CTL, 0, CTL_ZERO_BYTES, stream) != hipSuccess) return;
    Args a{};
    for (int i = 0; i < 31; ++i) a.in[i] = (const float*)d_in[i];
    a.out = (float*)d_out; a.ws = (unsigned char*)d_ws;
#if MK_PER_PHASE
    for (int p = 0; p < N_PHASES; ++p) { a.ph_lo = p; a.ph_hi = p + 1; hipLaunchKernelGGL(mk_fwd, dim3(grid), dim3(NTHR), LDS_BYTES, stream, a); }
#else
    a.ph_lo = 0; a.ph_hi = N_PHASES;
    void* kargs[] = {&a};
    hipError_t e = hipLaunchCooperativeKernel((const void*)mk_fwd, dim3(grid), dim3(NTHR), kargs, LDS_BYTES, stream);
    if (e != hipSuccess) fprintf(stderr, "kernel_launch: cooperative launch failed: %s (grid %d)\n", hipGetErrorString(e), grid);
#endif
}
```

```cpp
#include <hip/hip_runtime.h>
#include <hip/hip_bf16.h>
#include <cstdio>
#include <cstdint>

#ifndef MK_PER_PHASE
#define MK_PER_PHASE 0
#endif

#ifndef PROBE_A
#define PROBE_A -1
#endif
#ifndef PROBE_B
#define PROBE_B -1
#endif
#ifndef PROBE_AE
#define PROBE_AE (PROBE_A + 1)
#endif
#ifndef PROBE_BE
#define PROBE_BE (PROBE_B + 1)
#endif
#ifndef PROBE_FS
#define PROBE_FS 500
#endif
#ifndef PROBE_FSB
#define PROBE_FSB PROBE_FS
#endif
#ifndef PROBE_ATTV
#define PROBE_ATTV -1
#endif
#ifndef PROBE_CVT
#define PROBE_CVT -1
#endif
#ifndef PROBE_SSDV
#define PROBE_SSDV -1
#endif
#define PROBING (PROBE_A >= 0 || PROBE_B >= 0)

#define LAS __attribute__((address_space(3)))
typedef unsigned short bf16;
typedef short bf16x8 __attribute__((ext_vector_type(8)));
typedef float f32x4 __attribute__((ext_vector_type(4)));
typedef float f32x2 __attribute__((ext_vector_type(2)));
typedef float f32x16 __attribute__((ext_vector_type(16)));
typedef unsigned u32x4 __attribute__((ext_vector_type(4)));
typedef unsigned u32x2 __attribute__((ext_vector_type(2)));
typedef __bf16 bf16x2_t __attribute__((ext_vector_type(2)));

constexpr int DM = 1024, NB = 8, SEQ = 2048, CTXL = 256, NLAT = NB * SEQ, NCTX = NB * CTXL, NTOK = NLAT + NCTX;
constexpr int DFF = 2816, NMOD = 9, MODW = NMOD * DM, DIN = 6064;
constexpr float EPS = 1e-6f;
constexpr float QSCALE = 0.10206207261596577f * 1.4426950408889634f;
constexpr int NWAVES = 8, NTHR = 512;

__device__ __forceinline__ unsigned pk2(float lo, float hi) { f32x2 v = {lo, hi}; bf16x2_t b = __builtin_convertvector(v, bf16x2_t); return __builtin_bit_cast(unsigned, b); }
__device__ __forceinline__ bf16 f2bf(float f) { return (bf16)(pk2(f, 0.f) & 0xffffu); }
__device__ __forceinline__ float bf2f(bf16 b) { return __uint_as_float((unsigned)b << 16); }
__device__ __forceinline__ float bflo(unsigned w) { return __uint_as_float(w << 16); }
__device__ __forceinline__ float bfhi(unsigned w) { return __uint_as_float(w & 0xffff0000u); }
__device__ __forceinline__ u32x4 pack8(f32x4 a, f32x4 b) { u32x4 w; w.x = pk2(a[0], a[1]); w.y = pk2(a[2], a[3]); w.z = pk2(b[0], b[1]); w.w = pk2(b[2], b[3]); return w; }
__device__ __forceinline__ void unpack8(u32x4 w, float* f) { f[0] = bflo(w.x); f[1] = bfhi(w.x); f[2] = bflo(w.y); f[3] = bfhi(w.y); f[4] = bflo(w.z); f[5] = bfhi(w.z); f[6] = bflo(w.w); f[7] = bfhi(w.w); }
__device__ __forceinline__ float rcpf_(float x) { return __builtin_amdgcn_rcpf(x); }
__device__ __forceinline__ float rsqf_(float x) { return __builtin_amdgcn_rsqf(x); }
__device__ __forceinline__ float sigmoidf_(float x) { return rcpf_(1.0f + __expf(-x)); }
__device__ __forceinline__ float siluf_(float x) { return x * rcpf_(1.0f + __expf(-x)); }
__device__ __forceinline__ float gelu_tanh(float x) { const float y = 1.5957691216057308f * (x + 0.044715f * x * x * x); return x * rcpf_(1.0f + __expf(-y)); }
__device__ __forceinline__ f32x4 rcp1p_exp2_4(f32x4 t) { f32x4 e;
#pragma unroll
    for (int j = 0; j < 4; ++j) e[j] = __builtin_amdgcn_exp2f(t[j]);
    e = e + 1.0f;
#pragma unroll
    for (int j = 0; j < 4; ++j) e[j] = rcpf_(e[j]);
    return e; }
__device__ __forceinline__ f32x4 silu4(f32x4 x) { return x * rcp1p_exp2_4(x * -1.4426950408889634f); }
__device__ __forceinline__ f32x4 gelu_tanh4(f32x4 x) { const f32x4 t = x * x * 0.044715f + 1.0f; return x * rcp1p_exp2_4(x * t * (-1.5957691216057308f * 1.4426950408889634f)); }
__device__ __forceinline__ float softplusf_(float x) {
    const float e = __expf(-fabsf(x)); const float l = e < 0.01f ? e * (1.0f - e * (0.5f - e * (1.0f / 3.0f))) : __logf(1.0f + e); return fmaxf(x, 0.f) + l; }
__device__ __forceinline__ float wave_sum(float v) {
#pragma unroll
    for (int o = 1; o < 64; o <<= 1) v += __shfl_xor(v, o);
    return v;
}
__device__ __forceinline__ float sum_fq(float x) {
    auto a = __builtin_amdgcn_permlane16_swap(__float_as_uint(x), __float_as_uint(x), false, false); x = __uint_as_float(a[0]) + __uint_as_float(a[1]);
    auto b = __builtin_amdgcn_permlane32_swap(__float_as_uint(x), __float_as_uint(x), false, false); return __uint_as_float(b[0]) + __uint_as_float(b[1]); }
__device__ __forceinline__ float max_x32(float x) { auto b = __builtin_amdgcn_permlane32_swap(__float_as_uint(x), __float_as_uint(x), false, false); return fmaxf(__uint_as_float(b[0]), __uint_as_float(b[1])); }
__device__ __forceinline__ float sum_x32(float x) { auto b = __builtin_amdgcn_permlane32_swap(__float_as_uint(x), __float_as_uint(x), false, false); return __uint_as_float(b[0]) + __uint_as_float(b[1]); }
__device__ __forceinline__ int mod_row(int row) { return row < NLAT ? (row >> 11) : 8; }

namespace pg8 {
#define PG8_LAS __attribute__((address_space(3)))
typedef unsigned short bf16_t;
constexpr int BM = 256, BK = 64, HALF = 128, HTB = HALF * BK * 2, STAGE_BYTES = 8 * HTB, NXCD = 8, WGM = 4;
__host__ __device__ __forceinline__ int lds_byte(int r, int c) { const int st = (r >> 4) * 2 + (c >> 5), rr = r & 15, cc = c & 31, ob = rr * 64 + cc * 2; return st * 1024 + (ob ^ (((ob >> 9) & 1) << 5)); }
__host__ __device__ __forceinline__ void stage_rc(int b, int& R, int& C) { const int st = b / 1024, sb = b % 1024, swz = sb ^ (((sb >> 9) & 1) << 5); R = (st >> 1) * 16 + swz / 64; C = (st & 1) * 32 + (swz % 64) / 2; }
__host__ __device__ __forceinline__ int perm32(int rho) { const int n = rho >> 4, i = rho & 15; return 8 * (i >> 2) + 4 * n + (i & 3); }

struct Unit { int pm, pn, ks; };
struct Gemm { const bf16_t* A; const bf16_t* Bt; int M, N, K, lda, ldb; const bf16_t* A1; const bf16_t* A2; const bf16_t* B1; const bf16_t* B2; };

struct StaticOrder {
    static constexpr bool CHAIN = false; static constexpr bool BRANCH = false;
    int nM, nN, nwg, G, c;
    __host__ __device__ void init(int M, int N, int G_, int c_) { nM = M / BM; nN = N / BM; nwg = nM * nN; G = G_; c = c_; }
    __host__ __device__ bool next(int i, Unit& u) const {
        const long L = (long)i * G + c; if (L >= nwg) return false;
        int wgid = (int)L; { const int q = nwg / NXCD, r = nwg % NXCD, xcd = wgid % NXCD, off = wgid / NXCD; wgid = (xcd < r ? xcd * (q + 1) : r * (q + 1) + (xcd - r) * q) + off; }
        const int nig = WGM * nN, gid = wgid / nig, fm = gid * WGM, gsz = (nM - fm) < WGM ? (nM - fm) : WGM;
        u.pm = fm + ((wgid % nig) % gsz); u.pn = (wgid % nig) / gsz; u.ks = 0; return true;
    }
    __device__ __forceinline__ void a_ready(const Unit&) const {}
    __device__ __forceinline__ void done(const Unit&) const {}
};
struct SliceOrder {
    static constexpr bool CHAIN = false; static constexpr bool BRANCH = false;
    int nM, nN, S, nwg, G, c;
    __host__ __device__ void init(int M, int N, int S_, int G_, int c_) { nM = M / BM; nN = N / BM; S = S_; nwg = nM * nN * S; G = G_; c = c_; }
    __host__ __device__ bool next(int i, Unit& u) const {
        const long L = (long)i * G + c; if (L >= nwg) return false;
        const int s = (int)L % S, t = (int)L / S; u.pn = t % nN; u.pm = t / nN; u.ks = s; return true;
    }
    __device__ __forceinline__ void a_ready(const Unit&) const {}
    __device__ __forceinline__ void done(const Unit&) const {}
};

struct BranchOrder {
    static constexpr bool CHAIN = false; static constexpr bool BRANCH = true;
    int nM, nN, nwg, G, c;
    __host__ __device__ void init(int M, int N, int G_, int c_) { nM = M / BM; nN = N / BM; nwg = nM * nN * 3; G = G_; c = c_; }
    __host__ __device__ bool next(int i, Unit& u) const {
        const long L = (long)i * G + c; if (L >= nwg) return false;
        const int t = (int)L / 3; u.ks = (int)L % 3; u.pn = t % nN; u.pm = t / nN; return true;
    }
    __device__ __forceinline__ void a_ready(const Unit&) const {}
    __device__ __forceinline__ void done(const Unit&) const {}
};
struct ChainOrder {
    static constexpr bool CHAIN = true; static constexpr bool BRANCH = false;
    int nM, nN, nt, G, c;
    __host__ __device__ void init(int M, int N, int G_, int c_) { nM = M / BM; nN = N / BM; nt = nM * nN; G = G_; c = c_; }
    __host__ __device__ bool next(int i, Unit& u) const {
        const int seg = i % 3; const long t = (long)(i / 3) * G + c; if (t >= nt) return false;
        u.pn = (int)t % nN; u.pm = (int)t / nN; u.ks = seg; return true;
    }
    __device__ __forceinline__ void a_ready(const Unit&) const {}
    __device__ __forceinline__ void done(const Unit&) const {}
};
template <class F> struct Epi8 {
    static constexpr bool PERM = true, AFTER_DRAIN = false; F f;
    __device__ __forceinline__ void operator()(const f32x4 (&acc)[2][2][4][2], const Unit& u, int wr, int wc, int fr, int fq) const {
        asm volatile("" : "+v"(fr), "+v"(fq));
#pragma unroll
        for (int ai = 0; ai < 2; ++ai)
#pragma unroll
            for (int m = 0; m < 4; ++m) { const int row = u.pm * BM + ai * HALF + wr * 64 + m * 16 + fr;
#pragma unroll
                for (int bj = 0; bj < 2; ++bj) f(row, u.pn * BM + bj * HALF + wc * 32 + 8 * fq, acc[ai][bj][m][0], acc[ai][bj][m][1]); }
    }
};
template <class F> struct Epi4 {
    static constexpr bool PERM = false, AFTER_DRAIN = false; F f;
    __device__ __forceinline__ void operator()(const f32x4 (&acc)[2][2][4][2], const Unit& u, int wr, int wc, int fr, int fq) const {
        asm volatile("" : "+v"(fr), "+v"(fq));
#pragma unroll
        for (int ai = 0; ai < 2; ++ai)
#pragma unroll
            for (int m = 0; m < 4; ++m) { const int row = u.pm * BM + ai * HALF + wr * 64 + m * 16 + fr;
#pragma unroll
                for (int bj = 0; bj < 2; ++bj)
#pragma unroll
                    for (int n = 0; n < 2; ++n) f(row, u.pn * BM + bj * HALF + wc * 32 + n * 16 + 4 * fq, acc[ai][bj][m][n]); }
    }
};
template <class F> struct EpiGU {
    static constexpr bool PERM = true, AFTER_DRAIN = false; F f;
    __device__ __forceinline__ void operator()(const f32x4 (&acc)[2][2][4][2], const Unit& u, int wr, int wc, int fr, int fq) const {
        asm volatile("" : "+v"(fr), "+v"(fq));
#pragma unroll
        for (int ai = 0; ai < 2; ++ai)
#pragma unroll
            for (int m = 0; m < 4; ++m) { const int row = u.pm * BM + ai * HALF + wr * 64 + m * 16 + fr;
                f(row, u.pn * HALF + wc * 32 + 8 * fq, acc[ai][0][m][0], acc[ai][0][m][1], acc[ai][1][m][0], acc[ai][1][m][1]); }
    }
};

template <class Epi, class Sched, bool ALIGN_EPI = false, bool SP2 = false>
__device__ __forceinline__ void gemm_phase(PG8_LAS unsigned char* lds, const Gemm g, const Sched& S, const Epi& E, int tid) {
    asm volatile("" : "+v"(tid));
    const int wid = __builtin_amdgcn_readfirstlane(tid >> 6), lane = tid & 63, wr = wid >> 2, wc = wid & 3, fr = lane & 15, fq = lane >> 4;
    const int K = g.K, nt = K / BK;
    unsigned voffA[2], voffB[2];
#pragma unroll
    for (int i = 0; i < 2; ++i) { int R, C; stage_rc(tid * 16 + i * 8192, R, C); const int Rb = Epi::PERM ? ((R & ~31) + perm32(R & 31)) : R;
        voffA[i] = (unsigned)(R * g.lda + C) * 2u; voffB[i] = (unsigned)(Rb * g.ldb + C) * 2u; }
    const size_t kstep = (size_t)(BK * 2);
    const size_t hstepA = (size_t)HALF * g.lda * 2, hstepB = (size_t)HALF * g.ldb * 2;
    const size_t tstepA = 2 * hstepA, tstepB = 2 * hstepB;
    const unsigned ldsw = (unsigned)wid * 1024u;
    const int aoff = lds_byte(wr * 64 + fr, fq * 8), boff = lds_byte(wc * 32 + fr, fq * 8);
#define PG8_SA(b, h) (((b) * 2 + (h)) * HTB)
#define PG8_SB(b, h) ((4 + (b) * 2 + (h)) * HTB)
#define PG8_STAGE(bufoff, gbase, voff) do { _Pragma("unroll") for (int _i = 0; _i < 2; ++_i) \
        __builtin_amdgcn_global_load_lds((const unsigned*)((const char*)(gbase) + (voff)[_i]), (PG8_LAS unsigned*)(lds + (bufoff) + ldsw + _i * 8192), 16, 0, 0); } while (0)
#define PG8_LDA(dst, b, h) do { _Pragma("unroll") for (int m = 0; m < 4; ++m) _Pragma("unroll") for (int k = 0; k < 2; ++k) dst[m][k] = *(const PG8_LAS bf16x8*)(lds + PG8_SA(b, h) + aoff + m * 2048 + k * 1024); } while (0)
#define PG8_LDB(dst, b, h) do { _Pragma("unroll") for (int n = 0; n < 2; ++n) _Pragma("unroll") for (int k = 0; k < 2; ++k) dst[n][k] = *(const PG8_LAS bf16x8*)(lds + PG8_SB(b, h) + boff + n * 2048 + k * 1024); } while (0)
#define PG8_MMA(ai, bj, At, Bt) do { __builtin_amdgcn_s_setprio(1); _Pragma("unroll") for (int m = 0; m < 4; ++m) _Pragma("unroll") for (int n = 0; n < 2; ++n) _Pragma("unroll") for (int k = 0; k < 2; ++k) \
        acc[ai][bj][m][n] = __builtin_amdgcn_mfma_f32_16x16x32_bf16(Bt[n][k], At[m][k], acc[ai][bj][m][n], 0, 0, 0); __builtin_amdgcn_s_setprio(0); } while (0)
#define PG8_WAIT_V(n) asm volatile("s_waitcnt vmcnt(" #n ")" ::: "memory")
#define PG8_WAIT_L(n) asm volatile("s_waitcnt lgkmcnt(" #n ")" ::: "memory")
#define PG8_BAR __builtin_amdgcn_s_barrier()
#define PG8_SCHED __builtin_amdgcn_sched_barrier(0)
    Unit cur, nxt; int ui = 0;
    if (!S.next(0, cur)) return;
    f32x4 acc[2][2][4][2];
#pragma unroll
    for (int a = 0; a < 2; ++a)
#pragma unroll
        for (int b = 0; b < 2; ++b)
#pragma unroll
            for (int m = 0; m < 4; ++m)
#pragma unroll
                for (int n = 0; n < 2; ++n) acc[a][b][m][n] = (f32x4){0.f, 0.f, 0.f, 0.f};
    bf16x8 At[4][2], B0[2][2], B1[2][2];
    const size_t sstep = (size_t)g.K * 2;
#define PG8_UA(u_) ((Sched::CHAIN || Sched::BRANCH) ? (const char*)((u_).ks == 0 ? g.A : ((u_).ks == 1 ? g.A1 : g.A2)) + (size_t)(u_).pm * tstepA : (const char*)g.A + (size_t)(u_).pm * tstepA + (size_t)(u_).ks * sstep)
#define PG8_UB(u_) ((Sched::CHAIN || Sched::BRANCH) ? (const char*)((u_).ks == 0 ? g.Bt : ((u_).ks == 1 ? g.B1 : g.B2)) + (size_t)(u_).pn * tstepB : (const char*)g.Bt + (size_t)(u_).pn * tstepB + (size_t)(u_).ks * sstep)
    const char* cA = PG8_UA(cur); const char* cB = PG8_UB(cur);
    S.a_ready(cur);
    if constexpr (SP2) {
        PG8_STAGE(PG8_SB(0, 0), cB, voffB); PG8_STAGE(PG8_SB(0, 1), cB + hstepB, voffB); PG8_STAGE(PG8_SA(0, 0), cA, voffA); PG8_STAGE(PG8_SA(0, 1), cA + hstepA, voffA);
        if (wr == 1) PG8_BAR;
        PG8_WAIT_V(2); PG8_BAR;
        PG8_STAGE(PG8_SB(1, 0), cB + kstep, voffB); PG8_STAGE(PG8_SA(1, 0), cA + kstep, voffA); PG8_STAGE(PG8_SB(1, 1), cB + hstepB + kstep, voffB);
        PG8_WAIT_V(6); PG8_BAR;
    } else {
        PG8_STAGE(PG8_SB(0, 0), cB, voffB); PG8_STAGE(PG8_SA(0, 0), cA, voffA); PG8_STAGE(PG8_SB(0, 1), cB + hstepB, voffB); PG8_STAGE(PG8_SA(0, 1), cA + hstepA, voffA);
        if (wr == 1) PG8_BAR;
        PG8_WAIT_V(4); PG8_BAR;
        PG8_STAGE(PG8_SB(1, 0), cB + kstep, voffB); PG8_STAGE(PG8_SA(1, 0), cA + kstep, voffA); PG8_STAGE(PG8_SB(1, 1), cB + hstepB + kstep, voffB);
        PG8_WAIT_V(6); PG8_BAR;
    }
    for (;;) {
        const bool has_next = S.next(ui + 1, nxt);
        const char* nA = has_next ? PG8_UA(nxt) : cA; const char* nB = has_next ? PG8_UB(nxt) : cB;
#pragma clang loop unroll(disable)
        for (int t = 0; t < nt; t += 2) {
            const bool last = (t == nt - 2);
            const char* a1 = cA + (size_t)(t + 1) * kstep;
            const char* a2 = last ? nA : cA + (size_t)(t + 2) * kstep; const char* b2 = last ? nB : cB + (size_t)(t + 2) * kstep;
            const char* a3 = a2 + kstep; const char* b3 = b2 + kstep;
            if (last && has_next) S.a_ready(nxt);
            if constexpr (SP2) {
            PG8_LDB(B0, 0, 0); PG8_LDB(B1, 0, 1); PG8_SCHED; PG8_LDA(At, 0, 0); PG8_STAGE(PG8_SA(1, 1), a1 + hstepA, voffA);
            PG8_WAIT_V(8); PG8_WAIT_L(0); PG8_BAR; PG8_MMA(0, 0, At, B0); PG8_MMA(0, 1, At, B1); PG8_BAR; PG8_SCHED;
            PG8_LDA(At, 0, 1); PG8_STAGE(PG8_SB(0, 0), b2, voffB); PG8_STAGE(PG8_SB(0, 1), b2 + hstepB, voffB); PG8_STAGE(PG8_SA(0, 0), a2, voffA);
            PG8_WAIT_V(8); PG8_WAIT_L(0); PG8_BAR; PG8_MMA(1, 0, At, B0); PG8_MMA(1, 1, At, B1); PG8_BAR; PG8_SCHED;
            PG8_LDB(B0, 1, 0); PG8_LDB(B1, 1, 1); PG8_SCHED; PG8_LDA(At, 1, 0); PG8_STAGE(PG8_SA(0, 1), a2 + hstepA, voffA);
            PG8_WAIT_V(8); PG8_WAIT_L(0); PG8_BAR; PG8_MMA(0, 0, At, B0); PG8_MMA(0, 1, At, B1); PG8_BAR; PG8_SCHED;
            PG8_LDA(At, 1, 1); PG8_STAGE(PG8_SB(1, 0), b3, voffB); PG8_STAGE(PG8_SB(1, 1), b3 + hstepB, voffB); PG8_STAGE(PG8_SA(1, 0), a3, voffA);
            PG8_WAIT_V(8); PG8_WAIT_L(0); PG8_BAR; PG8_MMA(1, 0, At, B0); PG8_MMA(1, 1, At, B1); PG8_BAR; PG8_SCHED;
            } else {
            PG8_LDB(B0, 0, 0); PG8_SCHED; PG8_LDA(At, 0, 0); PG8_STAGE(PG8_SA(1, 1), a1 + hstepA, voffA);
            PG8_WAIT_L(8); PG8_BAR; PG8_WAIT_L(0); PG8_MMA(0, 0, At, B0); PG8_BAR; PG8_SCHED;
            PG8_LDB(B1, 0, 1); PG8_STAGE(PG8_SB(0, 0), b2, voffB);
            PG8_BAR; PG8_WAIT_L(0); PG8_MMA(0, 1, At, B1); PG8_BAR;
            PG8_LDA(At, 0, 1); PG8_STAGE(PG8_SA(0, 0), a2, voffA);
            PG8_BAR; PG8_WAIT_L(0); PG8_MMA(1, 0, At, B0); PG8_BAR; PG8_SCHED;
            PG8_STAGE(PG8_SB(0, 1), b2 + hstepB, voffB);
            PG8_WAIT_V(6); PG8_BAR; PG8_MMA(1, 1, At, B1); PG8_BAR;
            PG8_LDB(B0, 1, 0); PG8_SCHED; PG8_LDA(At, 1, 0); PG8_STAGE(PG8_SA(0, 1), a2 + hstepA, voffA);
            PG8_WAIT_L(8); PG8_BAR; PG8_WAIT_L(0); PG8_MMA(0, 0, At, B0); PG8_BAR; PG8_SCHED;
            PG8_LDB(B1, 1, 1); PG8_STAGE(PG8_SB(1, 0), b3, voffB);
            PG8_BAR; PG8_WAIT_L(0); PG8_MMA(0, 1, At, B1); PG8_BAR;
            PG8_LDA(At, 1, 1); PG8_STAGE(PG8_SA(1, 0), a3, voffA);
            PG8_BAR; PG8_WAIT_L(0); PG8_MMA(1, 0, At, B0); PG8_BAR; PG8_SCHED;
            PG8_STAGE(PG8_SB(1, 1), b3 + hstepB, voffB);
            PG8_WAIT_V(6); PG8_BAR; PG8_MMA(1, 1, At, B1); PG8_BAR;
            }
        }
        if constexpr (ALIGN_EPI) { if (wr == 0) PG8_BAR; }
        bool zero_acc = true;
        if constexpr (Sched::CHAIN) { E.chain(acc, cur, wr, wc, fr, fq); zero_acc = (cur.ks == 2); }
        else if constexpr (!Epi::AFTER_DRAIN) { E(acc, cur, wr, wc, fr, fq); S.done(cur); }
        if (!has_next) break;
        if (zero_acc) {
#pragma unroll
        for (int a = 0; a < 2; ++a)
#pragma unroll
            for (int b = 0; b < 2; ++b)
#pragma unroll
                for (int m = 0; m < 4; ++m)
#pragma unroll
                    for (int n = 0; n < 2; ++n) acc[a][b][m][n] = (f32x4){0.f, 0.f, 0.f, 0.f};
        }
        cur = nxt; cA = nA; cB = nB; ++ui;
        if constexpr (ALIGN_EPI) { if (wr == 1) PG8_BAR; }
    }
    PG8_WAIT_V(0);
    if constexpr (!ALIGN_EPI) { if (wr == 0) PG8_BAR; }
    PG8_BAR;
#undef PG8_UA
#undef PG8_UB
#undef PG8_SA
#undef PG8_SB
#undef PG8_STAGE
#undef PG8_LDA
#undef PG8_LDB
#undef PG8_MMA
#undef PG8_WAIT_V
#undef PG8_WAIT_L
#undef PG8_BAR
#undef PG8_SCHED
}
}

constexpr size_t MiB = 1u << 20;
constexpr size_t WS_CTL = 0, CTL_ZERO_BYTES = 2 * MiB;
constexpr size_t WS_MOD = 1 * MiB;
constexpr size_t WS_ROPE = 2 * MiB;
constexpr size_t WS_STAT = 3 * MiB;
constexpr size_t WS_RSSN = WS_STAT + 4 * (size_t)18432 * 4;
constexpr size_t WS_W = 4 * MiB;
constexpr size_t WS_XCTX = 56 * MiB;
constexpr size_t WS_H = 64 * MiB;
constexpr size_t WS_BIG = 100 * MiB;
constexpr size_t B_KVR = WS_BIG + 0 * MiB, B_QLAT = WS_BIG + 9 * MiB, B_AMLA = WS_BIG + 0 * MiB;
constexpr size_t B_XBCR = WS_BIG + 18 * MiB, B_YF = WS_BIG + 18 * MiB, B_YB = WS_BIG + 36 * MiB;
constexpr size_t B_UV = WS_BIG + 54 * MiB, B_SZ = WS_BIG + 90 * MiB;
constexpr size_t B_Q = WS_BIG + 108 * MiB, B_KN = WS_BIG + 135 * MiB, B_KRP = WS_BIG + 153 * MiB, B_V = WS_BIG + 155 * MiB, B_XBC = WS_BIG + 173 * MiB, B_DT = WS_BIG + 209 * MiB;
constexpr size_t B_GATES = WS_BIG + 108 * MiB, B_ACT = WS_BIG + 0 * MiB;
constexpr size_t B_SLAB = WS_BIG + 100 * MiB;
constexpr size_t B_H2 = WS_BIG + 140 * MiB;
constexpr size_t WS_SHW = WS_BIG + 216 * MiB;
constexpr size_t SHW_F1 = 0, SHW_INA = 8 * 5632, SHW_GATE = SHW_INA + 8 * 3072, SHW_F2 = SHW_GATE + 8 * 3072, SHW_LAYER = SHW_F2 + 8 * 5632;
constexpr size_t B_MSLAB = WS_BIG + 54 * MiB;
constexpr size_t B_GM = WS_BIG + 218 * MiB;
constexpr size_t B_XF = WS_BIG + 100 * MiB;
constexpr size_t WS_END = WS_BIG + 236 * MiB;
constexpr size_t W_F1I = 0, W_F1O = W_F1I + (size_t)5632 * 1024, W_F2I = W_F1O + (size_t)1024 * 2816, W_F2O = W_F2I + (size_t)5632 * 1024;
constexpr size_t W_INA = W_F2O + (size_t)1024 * 2816, W_GATE = W_INA + (size_t)3072 * 1024, W_UQ = W_GATE + (size_t)3072 * 1024, W_UKV = W_UQ + (size_t)768 * 256;
constexpr size_t W_MO = W_UKV + (size_t)1024 * 256, W_SO = W_MO + (size_t)1024 * 512, W_GO = W_SO + (size_t)1024 * 512, W_OUT = W_GO + (size_t)1024 * 512, W_GS = W_OUT + (size_t)1024 * 1024, W_ENDW = W_GS + (size_t)8 * 128 * 128;
static_assert(W_ENDW * 2 <= 52 * MiB, "weights fit");
constexpr int CW_BAR = 4096;
constexpr int CW_QUEUE = 16384;
constexpr int CW_TS = 32768;

constexpr int LDS_PHASE_BYTES = 147456;
constexpr int MISC_OFF = LDS_PHASE_BYTES;
constexpr int LDS_BYTES = LDS_PHASE_BYTES + 256;

#define XB_TMO      128
#define XB_XCNT(j)  (256  + 64 * (j))
#define XB_XSUB(j)  (1280 + 64 * (j))
#define XB_XGEN(j)  (2304 + 64 * (j))
#define XB_TOP      3328
#define XB_TOPGEN   3392
#define XCD_BAR_WORDS 3456
#define XB_SPIN_CAP (1u << 22)
__device__ __forceinline__ unsigned xb_ld(unsigned* p)              { return __hip_atomic_load(p, __ATOMIC_RELAXED, __HIP_MEMORY_SCOPE_AGENT); }
__device__ __forceinline__ unsigned xb_add(unsigned* p, unsigned v) { return __hip_atomic_fetch_add(p, v, __ATOMIC_RELAXED, __HIP_MEMORY_SCOPE_AGENT); }
__device__ __forceinline__ unsigned xb_xcc_id() { return (unsigned)__builtin_amdgcn_s_getreg((3 << 11) | 20) & 0xFu; }
#define XB_SPIN(cond, bar) do { unsigned _sp = 0; while (cond) { __builtin_amdgcn_s_sleep(1); \
    if ((++_sp & 255u) == 0u) { if (xb_ld(&(bar)[XB_TMO])) break; if (_sp > XB_SPIN_CAP) { atomicAdd(&(bar)[XB_TMO], 1u); break; } } } } while (0)
struct XcdBarrier { unsigned* bar; unsigned x; volatile LAS unsigned* st; };
__device__ __forceinline__ XcdBarrier xcd_barrier_post(unsigned* bar, volatile LAS unsigned* st) {
    XcdBarrier b; b.bar = bar; b.x = xb_xcc_id(); b.st = st;
    if (threadIdx.x == 0) (void)xb_add(&bar[XB_XCNT(b.x)], 1u);
    return b;
}
__device__ __forceinline__ void xcd_barrier_complete(unsigned* bar, unsigned x, unsigned& nloc, unsigned& nx) {
    const unsigned G = gridDim.x * gridDim.y * gridDim.z;
    unsigned sum, cnt, mine, sp = 0u;
    for (;;) {
        sum = 0u; cnt = 0u; mine = 0u;
#pragma unroll
        for (unsigned j = 0; j < 16; ++j) { const unsigned c = xb_ld(&bar[XB_XCNT(j)]); sum += c; cnt += (c > 0u) ? 1u : 0u; mine = (j == x) ? c : mine; }
        if (sum == G) break;
        __builtin_amdgcn_s_sleep(1);
        if ((++sp & 255u) == 0u) { if (xb_ld(&bar[XB_TMO])) break; if (sp > XB_SPIN_CAP) { atomicAdd(&bar[XB_TMO], 1u); break; } }
    }
    nloc = mine > 0u ? mine : 1u; nx = cnt > 0u ? cnt : 1u;
}
__device__ __forceinline__ void xcd_barrier(const XcdBarrier& b, int wave) {
    asm volatile("s_waitcnt vmcnt(0)" ::: "memory");
    __syncthreads();
    if (wave == 0 && __builtin_amdgcn_mbcnt_hi(~0u, __builtin_amdgcn_mbcnt_lo(~0u, 0u)) == 0u) {
        unsigned* bar = b.bar;
        __builtin_amdgcn_s_waitcnt(0);
        unsigned nloc = b.st[0], nx = b.st[1];
        if (nloc == 0u) { xcd_barrier_complete(bar, b.x, nloc, nx); b.st[0] = nloc; b.st[1] = nx; }
        const unsigned old = xb_add(&bar[XB_XSUB(b.x)], 1u);
        const unsigned gen = old / nloc;
        if (old + 1u == (gen + 1u) * nloc) {
            __builtin_amdgcn_fence(__ATOMIC_RELEASE, "agent");
            asm volatile("s_waitcnt vmcnt(0)" ::: "memory");
            const unsigned og = xb_add(&bar[XB_TOP], 1u);
            const unsigned tg = og / nx;
            if (og + 1u == (tg + 1u) * nx) xb_add(&bar[XB_TOPGEN], 1u);
            else XB_SPIN(xb_ld(&bar[XB_TOPGEN]) == tg, bar);
            __builtin_amdgcn_fence(__ATOMIC_ACQUIRE, "agent");
            xb_add(&bar[XB_XGEN(b.x)], 1u);
            asm volatile("s_waitcnt vmcnt(0)" ::: "memory");
        } else {
            XB_SPIN(xb_ld(&bar[XB_XGEN(b.x)]) == gen, bar);
            __builtin_amdgcn_fence(__ATOMIC_ACQUIRE, "agent");
            asm volatile("s_waitcnt vmcnt(0)" ::: "memory");
        }
    }
    __syncthreads();
}

struct Args { const float* in[31]; float* out; unsigned char* ws; int ph_lo, ph_hi; };
static_assert(sizeof(Args) == 272, "kernarg layout");
enum { I_X = 0, I_C, I_CTX, I_CCTX, I_WADA, I_BADA, I_NORMG, I_F1WI, I_F1WO, I_F2WI, I_F2WO, I_WIN, I_QNORM, I_WUQ, I_KVNORM, I_WUKV, I_WMO,
       I_CONVW, I_CONVB, I_ALOG, I_DTBIAS, I_SSMD, I_SSMNORM, I_WSO, I_GMNORM, I_GMWS, I_GMBS, I_GMWO, I_BGATE, I_WOUT, I_FNORM };

struct Frame {
    LAS unsigned char* lds;
    int tid, lane, wave, G, vcu, bid;
    size_t z;
    const __attribute__((address_space(4))) char* ka;
};
#define GAS __attribute__((address_space(1)))
#define KA_PTR(T, byteoff) ((T*)(*(GAS T* const __attribute__((address_space(4)))*)(F.ka + (byteoff))))
#define WS_BASE (KA_PTR(unsigned char, 256) + F.z)
#define WSP(T, off) ((T*)(WS_BASE + (off)))
#define INP(k) (KA_PTR(const float, 8 * (k)) + F.z)
#define OUTP (KA_PTR(float, 248) + F.z)
#define F2ALT ((bf16*)OUTP + (size_t)NLAT * DM)
#define XBP ((bf16*)OUTP)
#define WGT(off) (WSP(bf16, WS_W) + (off))

typedef _Float16 h16x2_t __attribute__((ext_vector_type(2)));
typedef _Float16 h16x4_t __attribute__((ext_vector_type(4)));
__device__ __forceinline__ u32x2 xs_pack(f32x4 v) {
#pragma unroll
    for (int j = 0; j < 4; ++j) v[j] = __builtin_amdgcn_fmed3f(v[j], -65504.f, 65504.f);
    const h16x4_t h = __builtin_convertvector(v, h16x4_t); return __builtin_bit_cast(u32x2, h); }
__device__ __forceinline__ f32x4 xs_unpack(u32x2 w) { const h16x4_t h = __builtin_bit_cast(h16x4_t, w); return __builtin_convertvector(h, f32x4); }
__device__ __forceinline__ const float* xrow_in(const Frame& F, int row, bool from_inputs) {
    if (from_inputs) return row < NLAT ? INP(I_X) + (size_t)row * DM : INP(I_CTX) + (size_t)(row - NLAT) * DM;
    return WSP(float, WS_XCTX) + (size_t)(row - NLAT) * DM;
}
__device__ __forceinline__ float* xrow_out(const Frame& F, int row) { return WSP(float, WS_XCTX) + (size_t)(row - NLAT) * DM; }

template <class Map> __device__ __forceinline__ void transpose_items(const Frame& F, int& base, int gw, int NGW, const float* W, int Ksrc, int Nsrc, bf16* WT, int Kdst, int Ndst, const float* kscale, Map map, bool nt_out = false) {
    LAS float* scr = (LAS float*)(F.lds + F.wave * 16640);
    const int nblk = Ndst / 64, nitems = (Kdst / 64) * nblk;
    const int first = (gw - (base % NGW) + NGW) % NGW;
    const int lk = F.lane >> 4, ln = (F.lane & 15) * 4;
    for (int item = first; item < nitems; item += NGW) {
        const int kb = item / nblk, nb = item - kb * nblk, k0 = 64 * kb, n0 = 64 * nb;
        const int sc = map(n0 + ln); const int scol = sc < 0 ? 0 : sc;
        f32x4 v[16];
#pragma unroll
        for (int i = 0; i < 16; ++i) { const int k = k0 + lk + 4 * i, kc = k < Ksrc ? k : Ksrc - 1; v[i] = __builtin_nontemporal_load((const f32x4*)(W + (size_t)kc * Nsrc + scol)); }
#pragma unroll
        for (int i = 0; i < 16; ++i) { const int k = k0 + lk + 4 * i, kc = k < Ksrc ? k : Ksrc - 1; float m = (sc >= 0 && k < Ksrc) ? 1.f : 0.f; if (kscale) m *= kscale[kc];
            LAS float* d = scr + (lk + 4 * i) * 65 + ln; d[0] = v[i][0] * m; d[1] = v[i][1] * m; d[2] = v[i][2] * m; d[3] = v[i][3] * m; }
        asm volatile("s_waitcnt lgkmcnt(0)" ::: "memory");
        const int c = F.lane & 7;
#pragma unroll
        for (int j = 0; j < 8; ++j) { const int n = (F.lane >> 3) + 8 * j; const LAS float* p = scr + (8 * c) * 65 + n;
            u32x4 o; o.x = pk2(p[0 * 65], p[1 * 65]); o.y = pk2(p[2 * 65], p[3 * 65]); o.z = pk2(p[4 * 65], p[5 * 65]); o.w = pk2(p[6 * 65], p[7 * 65]);
            if (nt_out) __builtin_nontemporal_store(o, (u32x4*)(WT + (size_t)(n0 + n) * Kdst + k0 + 8 * c)); else *(u32x4*)(WT + (size_t)(n0 + n) * Kdst + k0 + 8 * c) = o; }
        asm volatile("s_waitcnt lgkmcnt(0)" ::: "memory");
    }
    base += nitems;
}
struct MapId { __device__ __forceinline__ int operator()(int n) const { return n; } };
struct MapOff { int off; __device__ __forceinline__ int operator()(int n) const { return n + off; } };
struct MapFfnIn { __device__ __forceinline__ int operator()(int n) const { const int pn = n >> 8, j = n & 255; return j < 128 ? pn * 128 + j : DFF + pn * 128 + (j - 128); } };
__device__ __forceinline__ int rope_src(int w) { const int blk = w >> 3, half = (w >> 2) & 1, jj = w & 3, i = blk * 4 + jj; return half ? 16 + i : i; }
struct MapInA { __device__ __forceinline__ int operator()(int n) const {
    if (n < 128) return n;
    if (n < 160) return 128 + rope_src(n - 128);
    if (n < 176) return 1184 + (n - 160);
    if (n < 256) return -1;
    if (n < 1280) return 160 + (n - 256);
    if (n < 1536) return 1200 + (n - 1280);
    if (n < 2048) return 1456 + (n - 1536);
    return 1968 + (n - 2048);
} };
struct MapUq { __device__ __forceinline__ int operator()(int n) const {
    if (n < 512) return 96 * (n >> 6) + (n & 63);
    const int c = n - 512, h = c >> 5; return 96 * h + 64 + rope_src(c & 31);
} };

__device__ __forceinline__ void convert_set(const Frame& F, int l, int set, int idx, int nw, bf16* f2) {
    const int gw = idx * NWAVES + F.wave, NGW = nw * NWAVES; int base = 0;
    if (set == 0) {
        transpose_items(F, base, gw, NGW, INP(I_F2WI) + (size_t)l * DM * 2 * DFF, DM, 2 * DFF, f2, DM, 2 * DFF, nullptr, MapFfnIn{}, l > 0);
    } else if (set == 1) {
        transpose_items(F, base, gw, NGW, INP(I_F1WI) + (size_t)l * DM * 2 * DFF, DM, 2 * DFF, WGT(W_F1I), DM, 2 * DFF, nullptr, MapFfnIn{}, l > 0);
    } else if (set == 2) {
        transpose_items(F, base, gw, NGW, INP(I_F1WO) + (size_t)l * DFF * DM, DFF, DM, WGT(W_F1O), DFF, DM, nullptr, MapId{}, l > 0);
        transpose_items(F, base, gw, NGW, INP(I_WIN) + (size_t)l * DM * DIN, DM, DIN, WGT(W_INA), DM, 3072, nullptr, MapInA{}, l > 0);
    } else {
        transpose_items(F, base, gw, NGW, INP(I_F2WO) + (size_t)l * DFF * DM, DFF, DM, f2 + (W_F2O - W_F2I), DFF, DM, nullptr, MapId{}, l > 0);
        transpose_items(F, base, gw, NGW, INP(I_WIN) + (size_t)l * DM * DIN, DM, DIN, WGT(W_GATE), DM, 3072, nullptr, MapOff{2992}, l > 0);
        transpose_items(F, base, gw, NGW, INP(I_WUQ) + (size_t)l * 256 * 768, 256, 768, WGT(W_UQ), 256, 768, INP(I_QNORM) + l * 256, MapUq{}, l > 0);
        transpose_items(F, base, gw, NGW, INP(I_WUKV) + (size_t)l * 128 * 1024, 128, 1024, WGT(W_UKV), 256, 1024, INP(I_KVNORM) + l * 128, MapId{}, l > 0);
        transpose_items(F, base, gw, NGW, INP(I_WMO) + (size_t)l * 512 * 1024, 512, 1024, WGT(W_MO), 512, 1024, nullptr, MapId{}, l > 0);
        transpose_items(F, base, gw, NGW, INP(I_WSO) + (size_t)l * 512 * 1024, 512, 1024, WGT(W_SO), 512, 1024, nullptr, MapId{}, l > 0);
        transpose_items(F, base, gw, NGW, INP(I_GMWO) + (size_t)l * 512 * 1024, 512, 1024, WGT(W_GO), 512, 1024, nullptr, MapId{}, l > 0);
        transpose_items(F, base, gw, NGW, INP(I_WOUT) + (size_t)l * 1024 * 1024, 1024, 1024, WGT(W_OUT), 1024, 1024, nullptr, MapId{}, l > 0);
        const float* gs = INP(I_GMWS) + (size_t)l * 131072; bf16* gd = WGT(W_GS);
        for (int i = (idx * NTHR + F.tid) * 4; i < 131072; i += nw * NTHR * 4) { const f32x4 v = *(const f32x4*)(gs + i); u32x2 o; o.x = pk2(v[0], v[1]); o.y = pk2(v[2], v[3]); *(u32x2*)(gd + i) = o; }
    }
}
__device__ __forceinline__ void tail_convert(const Frame& F, int nwg, int set) {
    const int r = nwg % F.G; const bool sh = r > 0 && F.G - r >= 64;
    if (sh && F.bid < r) return;
    __syncthreads();
    convert_set(F, 1, set, sh ? F.bid - r : F.bid, sh ? F.G - r : F.G, F2ALT);
}

__device__ __forceinline__ void prologue_mod(const Frame& F) {
    LAS float* sc = (LAS float*)(F.lds);
    LAS float* red = (LAS float*)(F.lds + 36864);
    if (F.bid < 144) {
    for (int i = F.tid; i < 9 * 1024; i += NTHR) { const int r = i >> 10, k = i & 1023; const float v = r < 8 ? INP(I_C)[r * 1024 + k] : INP(I_CCTX)[k]; sc[i] = siluf_(v); }
    __syncthreads();
    for (int uu = F.bid; uu < 144; uu += F.G) {
        const int u = uu >> 1, ks = uu & 1; const int l = u / 36, j0 = (u % 36) * 256 + F.lane * 4;
        const float* W = INP(I_WADA) + (size_t)l * DM * MODW + j0;
        f32x4 a[9];
#pragma unroll
        for (int r = 0; r < 9; ++r) a[r] = (f32x4){0.f, 0.f, 0.f, 0.f};
        const int kb = ks * 512 + F.wave * 64;
        for (int k0 = kb; k0 < kb + 64; k0 += 8) { f32x4 w[8];
#pragma unroll
            for (int i = 0; i < 8; ++i) w[i] = __builtin_nontemporal_load((const f32x4*)(W + (size_t)(k0 + i) * MODW));
#pragma unroll
            for (int i = 0; i < 8; ++i)
#pragma unroll
                for (int r = 0; r < 9; ++r) a[r] += w[i] * sc[r * 1024 + k0 + i]; }
#pragma unroll
        for (int r = 0; r < 9; ++r) *(LAS f32x4*)(red + (F.wave * 9 + r) * 256 + F.lane * 4) = a[r];
        __syncthreads();
        for (int i = F.tid; i < 9 * 256; i += NTHR) { const int r = i >> 8, c = i & 255; float sm = 0.f;
#pragma unroll
            for (int w = 0; w < 8; ++w) sm += red[(w * 9 + r) * 256 + c];
            const int col = (u % 36) * 256 + c;
            atomicAdd(WSP(float, WS_MOD) + (size_t)(l * 9 + r) * MODW + col, ks == 0 ? sm + INP(I_BADA)[l * MODW + col] : sm); }
        __syncthreads();
    }
    }
    float* rope = WSP(float, WS_ROPE);
    for (int i = F.bid * NTHR + F.tid; i < 2048 * 16; i += F.G * NTHR) { const int t = i >> 4, j = i & 15; const float pos = (float)(j < 8 ? (t >> 6) : (t & 63));
        const float inv = powf(10000.0f, -(float)(j & 7) * 0.125f); const float ang = pos * inv; rope[2 * i] = cosf(ang); rope[2 * i + 1] = sinf(ang); }
}

template <class Map> __device__ __forceinline__ void shw_unit(const Frame& F, const float* W, int Nsrc, const float* shift  , float* out  , int Ndst, int cg, Map map, int half) {
    LAS float* sc = (LAS float*)(F.lds);
    LAS float* red = (LAS float*)(F.lds + 32768);
    __syncthreads();
    for (int i = F.tid; i < 8 * 1024; i += NTHR) sc[i] = shift[(size_t)(i >> 10) * MODW + (i & 1023)];
    __syncthreads();
    const int n0 = cg * 256 + F.lane * 4, scol = map(n0); const float* Wp = W + (scol < 0 ? 0 : scol);
    f32x4 a[8];
#pragma unroll
    for (int r = 0; r < 8; ++r) a[r] = (f32x4){0.f, 0.f, 0.f, 0.f};
    const int kb = half * 512 + F.wave * 64;
    for (int k0 = kb; k0 < kb + 64; k0 += 8) { f32x4 w[8];
#pragma unroll
        for (int i = 0; i < 8; ++i) w[i] = __builtin_nontemporal_load((const f32x4*)(Wp + (size_t)(k0 + i) * Nsrc));
#pragma unroll
        for (int i = 0; i < 8; ++i)
#pragma unroll
            for (int r = 0; r < 8; ++r) a[r] += w[i] * sc[r * 1024 + k0 + i]; }
    if (scol < 0) {
#pragma unroll
        for (int r = 0; r < 8; ++r) a[r] = (f32x4){0.f, 0.f, 0.f, 0.f}; }
#pragma unroll
    for (int r = 0; r < 8; ++r) *(LAS f32x4*)(red + (F.wave * 8 + r) * 256 + F.lane * 4) = a[r];
    __syncthreads();
    for (int i = F.tid; i < 8 * 256; i += NTHR) { const int r = i >> 8, c = i & 255; float sm = 0.f;
#pragma unroll
        for (int w = 0; w < 8; ++w) sm += red[(w * 8 + r) * 256 + c];
        atomicAdd(out + (size_t)r * Ndst + cg * 256 + c, sm); }
}
__device__ __forceinline__ void shw_phase(const Frame& F) {
    for (int uu = F.bid; uu < 228; uu += F.G) {
        const int p = uu >> 1, half = uu & 1, l = p < 46 ? 0 : 1, v = p < 46 ? 22 + p : p - 46; const float* modl = WSP(float, WS_MOD) + (size_t)l * 9 * MODW; float* shw = WSP(float, WS_SHW) + (size_t)l * SHW_LAYER;
        if (v < 22) shw_unit(F, INP(I_F1WI) + (size_t)l * DM * 2 * DFF, 2 * DFF, modl + 0 * DM, shw + SHW_F1, 2 * DFF, v, MapFfnIn{}, half);
        else if (v < 34) shw_unit(F, INP(I_WIN) + (size_t)l * DM * DIN, DIN, modl + 3 * DM, shw + SHW_INA, 3072, v - 22, MapInA{}, half);
        else if (v < 46) shw_unit(F, INP(I_WIN) + (size_t)l * DM * DIN, DIN, modl + 3 * DM, shw + SHW_GATE, 3072, v - 34, MapOff{2992}, half);
        else shw_unit(F, INP(I_F2WI) + (size_t)l * DM * 2 * DFF, 2 * DFF, modl + 6 * DM, shw + SHW_F2, 2 * DFF, v - 46, MapFfnIn{}, half);
    }
}

__device__ __forceinline__ void norm_phase(const Frame& F, int l, int which, bool lat_in, bool ctx_in, int row0, int nrows, int nslabs, bf16* H) {
    const int gw = F.vcu * NWAVES + F.wave, NGW = F.G * NWAVES;
    const float* g = INP(I_NORMG) + (l * 3 + which) * DM; const float* slab = WSP(float, B_SLAB);
    f32x4 v[4], nv[4];
    int row = row0 + gw;
    if (row < nrows) { const f32x4* xr = (const f32x4*)xrow_in(F, row, row < NLAT ? lat_in : ctx_in) + F.lane;
#pragma unroll
        for (int j = 0; j < 4; ++j) nv[j] = __builtin_nontemporal_load(xr + 64 * j); }
    for (; row < nrows; row += NGW) {
#pragma unroll
        for (int j = 0; j < 4; ++j) v[j] = nv[j];
        const int nrow = row + NGW;
        if (nrow < nrows) { const f32x4* xr = (const f32x4*)xrow_in(F, nrow, nrow < NLAT ? lat_in : ctx_in) + F.lane;
#pragma unroll
            for (int j = 0; j < 4; ++j) nv[j] = __builtin_nontemporal_load(xr + 64 * j); }
        if (nslabs > 0 && row >= NLAT) {
            f32x4 sv[4][4];
#pragma unroll
            for (int sidx = 0; sidx < 4; ++sidx) { const f32x4* sr = (const f32x4*)(slab + ((size_t)sidx * NCTX + (row - NLAT)) * DM) + F.lane;
#pragma unroll
                for (int j = 0; j < 4; ++j) sv[sidx][j] = sr[64 * j]; }
#pragma unroll
            for (int sidx = 0; sidx < 4; ++sidx)
#pragma unroll
                for (int j = 0; j < 4; ++j) v[j] += sv[sidx][j];
            f32x4* xo = (f32x4*)xrow_out(F, row) + F.lane;
#pragma unroll
            for (int j = 0; j < 4; ++j) xo[64 * j] = v[j];
        }
        if (lat_in && row < NLAT) { u32x2* xb = (u32x2*)(XBP + (size_t)row * DM) + F.lane;
#pragma unroll
            for (int j = 0; j < 4; ++j) xb[64 * j] = xs_pack(v[j]); }
        const float* mod = WSP(float, WS_MOD) + (size_t)(l * 9 + mod_row(row)) * MODW + (3 * which) * DM;
        float sq = 0.f;
#pragma unroll
        for (int j = 0; j < 4; ++j) sq += (v[j][0] * v[j][0] + v[j][1] * v[j][1]) + (v[j][2] * v[j][2] + v[j][3] * v[j][3]);
        const float r = rsqf_(wave_sum(sq) * (1.f / DM) + EPS);
        u32x2* o = (u32x2*)(H + (size_t)row * DM) + F.lane;
#pragma unroll
        for (int j = 0; j < 4; ++j) { const int c = 4 * F.lane + 256 * j; const f32x4 gg = *(const f32x4*)(g + c), sh = *(const f32x4*)(mod + c), scl = *(const f32x4*)(mod + DM + c);
            const f32x4 y = v[j] * r * gg * (scl + 1.0f) + sh; u32x2 w; w.x = pk2(y[0], y[1]); w.y = pk2(y[2], y[3]); o[64 * j] = w; }
    }
}
__device__ __forceinline__ void zero_stats(const Frame& F) {
    float* st = WSP(float, WS_STAT);
    for (int i = F.bid * NTHR + F.tid; i < 4 * NTOK; i += F.G * NTHR) st[i] = 0.f;
}
__device__ __forceinline__ void merge_ctx_sum(const Frame& F) {
    const int gw = F.vcu * NWAVES + F.wave, NGW = F.G * NWAVES; const float* slab = WSP(float, B_MSLAB); bf16* MG = WSP(bf16, WS_H) + (size_t)NLAT * DM;
    for (int row = gw; row < NCTX; row += NGW) {
#pragma unroll
        for (int j = 0; j < 4; ++j) { const size_t o = (size_t)row * DM + 4 * F.lane + 256 * j;
            const f32x4 v = *(const f32x4*)(slab + o) + *(const f32x4*)(slab + (size_t)NCTX * DM + o) + *(const f32x4*)(slab + 2 * (size_t)NCTX * DM + o);
            u32x2 w; w.x = pk2(v[0], v[1]); w.y = pk2(v[2], v[3]); *(u32x2*)(MG + o) = w; }
    }
}
__device__ __forceinline__ void zero_rssn(const Frame& F, int first, int count) {
    float* st = WSP(float, WS_RSSN) + (size_t)first * NLAT;
    for (int i = F.bid * NTHR + F.tid; i < count * NLAT; i += F.G * NTHR) st[i] = 0.f;
}
__device__ __forceinline__ void final_norm(const Frame& F) {
    const int gw = F.vcu * NWAVES + F.wave, NGW = F.G * NWAVES; const float* g = INP(I_FNORM);
    f32x4 gg[4];
#pragma unroll
    for (int j = 0; j < 4; ++j) gg[j] = *(const f32x4*)(g + 4 * F.lane + 256 * j);
    for (int row0 = gw; row0 < NLAT; row0 += 2 * NGW) {
        u32x2 raw[2][4];
#pragma unroll
        for (int k = 0; k < 2; ++k) { const int row = row0 + k * NGW < NLAT ? row0 + k * NGW : row0; const u32x2* xr = (const u32x2*)(WSP(bf16, B_XF) + (size_t)row * DM) + F.lane;
#pragma unroll
            for (int j = 0; j < 4; ++j) raw[k][j] = xr[64 * j]; }
        f32x4 v[2][4]; float s[2];
#pragma unroll
        for (int k = 0; k < 2; ++k) { s[k] = 0.f;
#pragma unroll
            for (int j = 0; j < 4; ++j) { v[k][j] = xs_unpack(raw[k][j]); s[k] += (v[k][j][0] * v[k][j][0] + v[k][j][1] * v[k][j][1]) + (v[k][j][2] * v[k][j][2] + v[k][j][3] * v[k][j][3]); } }
#pragma unroll
        for (int o = 1; o < 64; o <<= 1) { s[0] += __shfl_xor(s[0], o); s[1] += __shfl_xor(s[1], o); }
#pragma unroll
        for (int k = 0; k < 2; ++k) { const int row = row0 + k * NGW; if (row < NLAT) { const float r = 1.0f / sqrtf(s[k] * (1.f / DM) + EPS); f32x4* xw = (f32x4*)(OUTP + (size_t)row * DM) + F.lane;
#pragma unroll
            for (int j = 0; j < 4; ++j) __builtin_nontemporal_store(v[k][j] * r * gg[j], xw + 64 * j); } }
    }
}
__device__ __forceinline__ void conv_phase(const Frame& F, int l, int nrows) {
    const bf16* src = WSP(bf16, B_XBCR); bf16* dst = WSP(bf16, B_XBC);
    const float* cw = INP(I_CONVW) + (size_t)l * 1024 * 5; const float* cb = INP(I_CONVB) + l * 1024;
    const int nitems = (nrows / 8) * 128;
    for (int it = F.bid * NTHR + F.tid; it < nitems; it += F.G * NTHR) {
        const int cg = it & 127, rb = it >> 7, c0 = cg * 8, R = rb * 8;
        int s0, s1; if (R < NLAT) { s0 = R & ~2047; s1 = s0 + 2048; } else { s0 = NLAT + ((R - NLAT) & ~255); s1 = s0 + 256; }
        u32x4 raw[12];
#pragma unroll
        for (int k = 0; k < 12; ++k) { const int r = R - 2 + k; raw[k] = (u32x4){0u, 0u, 0u, 0u}; if (r >= s0 && r < s1) raw[k] = *(const u32x4*)(src + (size_t)r * 1024 + c0); }
        float wf[40];
#pragma unroll
        for (int q = 0; q < 10; ++q) { const f32x4 t = *(const f32x4*)(cw + (size_t)c0 * 5 + 4 * q); wf[4 * q] = t[0]; wf[4 * q + 1] = t[1]; wf[4 * q + 2] = t[2]; wf[4 * q + 3] = t[3]; }
        f32x4 wv[5][2];
#pragma unroll
        for (int k = 0; k < 5; ++k)
#pragma unroll
            for (int h2 = 0; h2 < 2; ++h2) wv[k][h2] = (f32x4){wf[(4 * h2) * 5 + k], wf[(4 * h2 + 1) * 5 + k], wf[(4 * h2 + 2) * 5 + k], wf[(4 * h2 + 3) * 5 + k]};
        const f32x4 b0 = *(const f32x4*)(cb + c0), b1 = *(const f32x4*)(cb + c0 + 4);
        f32x4 acc[8][2];
#pragma unroll
        for (int o = 0; o < 8; ++o) { acc[o][0] = b0; acc[o][1] = b1; }
#pragma unroll
        for (int k = 0; k < 12; ++k) { float x[8]; unpack8(raw[k], x); const f32x4 x0 = (f32x4){x[0], x[1], x[2], x[3]}, x1 = (f32x4){x[4], x[5], x[6], x[7]};
#pragma unroll
            for (int o = 0; o < 8; ++o) { const int tap = k - o;
                if (tap >= 0 && tap < 5) { acc[o][0] += wv[tap][0] * x0; acc[o][1] += wv[tap][1] * x1; } } }
#pragma unroll
        for (int o = 0; o < 8; ++o) { const u32x4 ov = pack8(silu4(acc[o][0]), silu4(acc[o][1]));
            *(u32x4*)(dst + (size_t)(R + o) * 1024 + c0) = ov; }
    }
}
__device__ __forceinline__ void ssm_out_prep(const Frame& F, int l, int nrows) {
    const int gw = F.vcu * NWAVES + F.wave, NGW = F.G * NWAVES; const float* g = INP(I_SSMNORM) + l * 512;
    bf16* YF = WSP(bf16, B_YF); const bf16* YB = WSP(bf16, B_YB); const bf16* SZ = WSP(bf16, B_SZ);
    float gg[8];
#pragma unroll
    for (int c = 0; c < 8; ++c) gg[c] = g[F.lane * 8 + c];
    for (int row0 = gw; row0 < nrows; row0 += 3 * NGW) {
        u32x4 ra[3], rb[3], rz[3];
#pragma unroll
        for (int k = 0; k < 3; ++k) { const int row = row0 + k * NGW; const size_t o = (size_t)(row < nrows ? row : row0) * 512 + F.lane * 8; ra[k] = *(const u32x4*)(YF + o); rb[k] = *(const u32x4*)(YB + o); rz[k] = *(const u32x4*)(SZ + o); }
        float a[3][8], s[3];
#pragma unroll
        for (int k = 0; k < 3; ++k) { float b[8], z[8]; unpack8(ra[k], a[k]); unpack8(rb[k], b); unpack8(rz[k], z); s[k] = 0.f;
#pragma unroll
            for (int c = 0; c < 8; ++c) { a[k][c] = (a[k][c] + b[c]) * z[c]; s[k] += a[k][c] * a[k][c]; } }
#pragma unroll
        for (int o = 1; o < 64; o <<= 1) {
#pragma unroll
            for (int k = 0; k < 3; ++k) s[k] += __shfl_xor(s[k], o); }
#pragma unroll
        for (int k = 0; k < 3; ++k) { const int row = row0 + k * NGW; if (row < nrows) { const float r = 1.0f / sqrtf(s[k] * (1.f / 512.f) + EPS);
            u32x4 ov; ov.x = pk2(a[k][0] * r * gg[0], a[k][1] * r * gg[1]); ov.y = pk2(a[k][2] * r * gg[2], a[k][3] * r * gg[3]); ov.z = pk2(a[k][4] * r * gg[4], a[k][5] * r * gg[5]); ov.w = pk2(a[k][6] * r * gg[6], a[k][7] * r * gg[7]);
            *(u32x4*)(YF + (size_t)row * 512 + F.lane * 8) = ov; } }
    }
}

#define EPI_RED_OFF 131072
__device__ __forceinline__ void epi_row_atomics(const float (&pa)[8], const float (&pb)[8], float* dsta, float* dstb  , int wr, int wc, int fr, int fq, int tid) {
    LAS float* red = (LAS float*)(unsigned)EPI_RED_OFF;
    if (fq == 0) {
#pragma unroll
        for (int i = 0; i < 8; ++i) { const int o = wc * 256 + (i >> 2) * 128 + wr * 64 + (i & 3) * 16 + fr; red[o] = pa[i]; if (dstb) red[1024 + o] = pb[i]; } }
    asm volatile("s_waitcnt lgkmcnt(0)" ::: "memory"); __builtin_amdgcn_s_barrier(); asm volatile("" ::: "memory");
    if (tid < 256) { const float v = (red[tid] + red[256 + tid]) + (red[512 + tid] + red[768 + tid]); atomicAdd(dsta + tid, v); }
    else if (dstb) { const int t = tid - 256; const float v = (red[1024 + t] + red[1280 + t]) + (red[1536 + t] + red[1792 + t]); atomicAdd(dstb + t, v); }
}
struct EpiSwiglu {
    static constexpr bool PERM = true, AFTER_DRAIN = false;
    bf16* ACT; const float* rss; const float* shw; int fused;
    __device__ __forceinline__ void operator()(const f32x4 (&acc)[2][2][4][2], const pg8::Unit& u, int wr, int wc, int fr, int fq) const {
        asm volatile("" : "+v"(fr), "+v"(fq));
        bf16* act_ = ACT; const bool fz = fused && (u.pm * 256 < NLAT);
        const int oc = u.pn * 128 + wc * 32 + 8 * fq, row0 = u.pm * 256 + wr * 64 + fr;
        f32x4 sh[4]; float rr[8];
#pragma unroll
        for (int i = 0; i < 4; ++i) sh[i] = (f32x4){0.f, 0.f, 0.f, 0.f};
#pragma unroll
        for (int i = 0; i < 8; ++i) rr[i] = 1.f;
        if (fz) { const float* sp = shw + (size_t)(u.pm >> 3) * (2 * DFF) + u.pn * 256 + wc * 32 + 8 * fq; sh[0] = *(const f32x4*)(sp); sh[1] = *(const f32x4*)(sp + 4); sh[2] = *(const f32x4*)(sp + 128); sh[3] = *(const f32x4*)(sp + 132);
#pragma unroll
            for (int i = 0; i < 8; ++i) rr[i] = rss[row0 + (i >> 2) * 128 + (i & 3) * 16];
#pragma unroll
            for (int i = 0; i < 8; ++i) rr[i] = rsqf_(rr[i] * (1.f / DM) + EPS); }
        constexpr float CG = -1.4426950408889634f, CU = -0.6931471805599453f;
        sh[0] *= CG; sh[1] *= CG; sh[2] *= CU; sh[3] *= CU;
#pragma unroll
        for (int ai = 0; ai < 2; ++ai)
#pragma unroll
            for (int m = 0; m < 4; ++m) { const int row = row0 + ai * 128 + m * 16; const float rg = rr[ai * 4 + m] * CG, ru = rr[ai * 4 + m] * CU;
                const f32x4 g0 = acc[ai][0][m][0] * rg + sh[0], g1 = acc[ai][0][m][1] * rg + sh[1], u0 = acc[ai][1][m][0] * ru + sh[2], u1 = acc[ai][1][m][1] * ru + sh[3];
                f32x4 e0, e1;
#pragma unroll
                for (int j = 0; j < 4; ++j) { e0[j] = __builtin_amdgcn_exp2f(g0[j]); e1[j] = __builtin_amdgcn_exp2f(g1[j]); }
                e0 = e0 + 1.0f; e1 = e1 + 1.0f;
#pragma unroll
                for (int j = 0; j < 4; ++j) { e0[j] = rcpf_(e0[j]); e1[j] = rcpf_(e1[j]); }
                const f32x4 a0 = g0 * u0 * e0, a1 = g1 * u1 * e1;
                *(u32x4*)(act_ + (size_t)row * DFF + oc) = pack8(a0, a1); }
    }
};
struct FResid { const bf16* xb; bf16* out; const float* mod; int gate_idx; float coef;
    __device__ __forceinline__ void operator()(int row, int col, f32x4 v0, f32x4 v1) const {
        const bf16* a_ = xb; bf16* o_ = out; const float* m_ = mod; const int gi = gate_idx; const float cf = coef;
        const size_t off = (size_t)row * DM + col;
        const float* gp = m_ + (size_t)mod_row(row) * MODW + gi * DM + col;
        const f32x4 g0 = *(const f32x4*)(gp), g1 = *(const f32x4*)(gp + 4);
        const u32x4 xo = *(const u32x4*)(a_ + off);
        const u32x2 p0 = xs_pack(xs_unpack((u32x2){xo.x, xo.y}) + g0 * v0 * cf), p1 = xs_pack(xs_unpack((u32x2){xo.z, xo.w}) + g1 * v1 * cf);
        *(u32x4*)(o_ + off) = (u32x4){p0.x, p0.y, p1.x, p1.y};
    } };
struct EpiResidN {
    static constexpr bool PERM = true, AFTER_DRAIN = false;
    bf16* xs; const float* mod; const float* modn; const float* gnorm; float* rss; bf16* Hn; int gate_idx, which_next; float coef;
    __device__ __forceinline__ void operator()(const f32x4 (&acc)[2][2][4][2], const pg8::Unit& u, int wr, int wc, int fr, int fq) const {
        asm volatile("" : "+v"(fr), "+v"(fq));
        bf16* x_ = xs; bf16* h_ = Hn; float* rss_ = rss; const float cf = coef;
        const int b = u.pm >> 3, c0 = u.pn * 256 + wc * 32 + 8 * fq, row0 = u.pm * 256 + wr * 64 + fr;
        float part[8]; const int tid_ = (wr * 4 + wc) * 64 + fq * 16 + fr;
#pragma unroll
        for (int q = 0; q < 8; ++q) part[q] = 0.f;
#pragma unroll
        for (int bj = 0; bj < 2; ++bj) {
            f32x4 gt[2], gs[2];
#pragma unroll
            for (int n = 0; n < 2; ++n) { const int col = c0 + bj * 128 + n * 4;
                gt[n] = *(const f32x4*)(mod + (size_t)b * MODW + gate_idx * DM + col) * cf;
                gs[n] = *(const f32x4*)(gnorm + col) * (*(const f32x4*)(modn + (size_t)b * MODW + (3 * which_next + 1) * DM + col) + 1.0f); }
#pragma unroll
            for (int ai = 0; ai < 2; ++ai) {
            u32x4 xo[4];
#pragma unroll
            for (int m = 0; m < 4; ++m) xo[m] = __builtin_nontemporal_load((const u32x4*)(x_ + (size_t)(row0 + ai * 128 + m * 16) * DM + c0 + bj * 128));
#pragma unroll
            for (int m = 0; m < 4; ++m) { const int q = ai * 4 + m; const size_t ro = (size_t)(row0 + ai * 128 + m * 16) * DM + c0 + bj * 128;
                const f32x4 xa = xs_unpack((u32x2){xo[m].x, xo[m].y}) + gt[0] * acc[ai][bj][m][0], xb = xs_unpack((u32x2){xo[m].z, xo[m].w}) + gt[1] * acc[ai][bj][m][1];
                const u32x2 pa = xs_pack(xa), pb = xs_pack(xb);
                __builtin_nontemporal_store((u32x4){pa.x, pa.y, pb.x, pb.y}, (u32x4*)(x_ + ro));
                part[q] += ((xa[0] * xa[0] + xa[1] * xa[1]) + (xa[2] * xa[2] + xa[3] * xa[3])) + ((xb[0] * xb[0] + xb[1] * xb[1]) + (xb[2] * xb[2] + xb[3] * xb[3]));
                *(u32x4*)(h_ + ro) = pack8(xa * gs[0], xb * gs[1]); } }
        }
#pragma unroll
        for (int q = 0; q < 8; ++q) part[q] = sum_fq(part[q]);
        epi_row_atomics(part, part, rss_ + u.pm * 256, nullptr, wr, wc, fr, fq, tid_);
    }
};
struct EpiSlab {
    static constexpr bool PERM = false, AFTER_DRAIN = false;
    float* slab; const float* mod; int gate_idx, ks0; float coef;
    __device__ __forceinline__ void operator()(const f32x4 (&acc)[2][2][4][2], const pg8::Unit& u, int wr, int wc, int fr, int fq) const {
        asm volatile("" : "+v"(fr), "+v"(fq));
        float* sl = slab + (size_t)(ks0 + u.ks) * NCTX * DM; const float* md = mod + (size_t)8 * MODW + gate_idx * DM; const float cf = coef;
#pragma unroll
        for (int ai = 0; ai < 2; ++ai)
#pragma unroll
            for (int m = 0; m < 4; ++m) { const int row = u.pm * 256 + ai * 128 + wr * 64 + m * 16 + fr;
#pragma unroll
                for (int bj = 0; bj < 2; ++bj)
#pragma unroll
                    for (int n = 0; n < 2; ++n) { const int col = u.pn * 256 + bj * 128 + wc * 32 + n * 16 + 4 * fq;
                        *(f32x4*)(sl + (size_t)row * DM + col) = *(const f32x4*)(md + col) * acc[ai][bj][m][n] * cf; } }
    }
};
struct EpiGates {
    static constexpr bool PERM = true, AFTER_DRAIN = false;
    bf16* GATES; const float* bg; const float* rss; const float* shw;
    __device__ __forceinline__ void operator()(const f32x4 (&acc)[2][2][4][2], const pg8::Unit& u, int wr, int wc, int fr, int fq) const {
        asm volatile("" : "+v"(fr), "+v"(fq));
        bf16* gt_ = GATES; const bool fz = (u.pm * 256 < NLAT);
        const int c0 = u.pn * 256 + wc * 32 + 8 * fq, row0 = u.pm * 256 + wr * 64 + fr;
        f32x4 sh[2][2]; float rr[8];
#pragma unroll
        for (int bj = 0; bj < 2; ++bj) { sh[bj][0] = *(const f32x4*)(bg + c0 + bj * 128); sh[bj][1] = *(const f32x4*)(bg + c0 + bj * 128 + 4); }
#pragma unroll
        for (int i = 0; i < 8; ++i) rr[i] = 1.f;
        if (fz) { const float* sp = shw + (size_t)(u.pm >> 3) * 3072 + c0;
#pragma unroll
            for (int bj = 0; bj < 2; ++bj) { sh[bj][0] += *(const f32x4*)(sp + bj * 128); sh[bj][1] += *(const f32x4*)(sp + bj * 128 + 4); }
#pragma unroll
            for (int i = 0; i < 8; ++i) rr[i] = rss[row0 + (i >> 2) * 128 + (i & 3) * 16];
#pragma unroll
            for (int i = 0; i < 8; ++i) rr[i] = rsqf_(rr[i] * (1.f / DM) + EPS); }
#pragma unroll
        for (int bj = 0; bj < 2; ++bj) { sh[bj][0] *= -1.4426950408889634f; sh[bj][1] *= -1.4426950408889634f; }
#pragma unroll
        for (int ai = 0; ai < 2; ++ai)
#pragma unroll
            for (int m = 0; m < 4; ++m) { const int row = row0 + ai * 128 + m * 16; const float r = rr[ai * 4 + m] * -1.4426950408889634f;
#pragma unroll
                for (int bj = 0; bj < 2; ++bj) { const f32x4 a0 = rcp1p_exp2_4(acc[ai][bj][m][0] * r + sh[bj][0]), a1 = rcp1p_exp2_4(acc[ai][bj][m][1] * r + sh[bj][1]);
                    *(u32x4*)(gt_ + (size_t)row * 3072 + c0 + bj * 128) = pack8(a0, a1); } }
    }
};
struct EpiMergeChain {
    static constexpr bool PERM = true, AFTER_DRAIN = false;
    const bf16* GATES; bf16* MERGED;
    __device__ __forceinline__ void operator()(const f32x4 (&)[2][2][4][2], const pg8::Unit&, int, int, int, int) const {}
    __device__ __forceinline__ void chain(f32x4 (&acc)[2][2][4][2], const pg8::Unit& u, int wr, int wc, int fr, int fq) const {
        asm volatile("" : "+v"(fr), "+v"(fq));
        const bf16* gt_ = GATES; bf16* mg_ = MERGED; const int ks = u.ks;
        const int c0 = u.pn * 256 + wc * 32 + 8 * fq, row0 = u.pm * 256 + wr * 64 + fr;
#pragma unroll
        for (int ai = 0; ai < 2; ++ai) {
            u32x4 gn[4][2], gd[4][2];
#pragma unroll
            for (int m = 0; m < 4; ++m)
#pragma unroll
                for (int bj = 0; bj < 2; ++bj) { const bf16* gp = gt_ + (size_t)(row0 + ai * 128 + m * 16) * 3072 + c0 + bj * 128;
                    gn[m][bj] = *(const u32x4*)(gp + ks * 1024); gd[m][bj] = gn[m][bj]; if (ks < 2) gd[m][bj] = *(const u32x4*)(gp + (ks + 1) * 1024); }
#pragma unroll
            for (int m = 0; m < 4; ++m)
#pragma unroll
                for (int bj = 0; bj < 2; ++bj) { float f[8]; unpack8(gn[m][bj], f);
                    if (ks < 2) { float d[8]; unpack8(gd[m][bj], d);
#pragma unroll
                        for (int j = 0; j < 8; ++j) f[j] *= rcpf_(fmaxf(d[j], 1e-30f)); }
#pragma unroll
                    for (int j = 0; j < 4; ++j) { acc[ai][bj][m][0][j] *= f[j]; acc[ai][bj][m][1][j] *= f[4 + j]; }
                    if (ks == 2) *(u32x4*)(mg_ + (size_t)(row0 + ai * 128 + m * 16) * DM + c0 + bj * 128) = pack8(acc[ai][bj][m][0], acc[ai][bj][m][1]); }
        }
    }
};
struct EpiMergeSlab {
    static constexpr bool PERM = true, AFTER_DRAIN = false;
    const bf16* GATES; float* slab;
    __device__ __forceinline__ void operator()(const f32x4 (&acc)[2][2][4][2], const pg8::Unit& u, int wr, int wc, int fr, int fq) const {
        asm volatile("" : "+v"(fr), "+v"(fq));
        const bf16* gt_ = GATES + (size_t)NLAT * 3072 + u.ks * 1024; float* sl = slab + (size_t)u.ks * NCTX * DM;
        const int c0 = u.pn * 256 + wc * 32 + 8 * fq, row0 = u.pm * 256 + wr * 64 + fr;
#pragma unroll
        for (int ai = 0; ai < 2; ++ai)
#pragma unroll
            for (int m = 0; m < 4; ++m) { const int row = row0 + ai * 128 + m * 16;
#pragma unroll
                for (int bj = 0; bj < 2; ++bj) { float f[8]; unpack8(*(const u32x4*)(gt_ + (size_t)row * 3072 + c0 + bj * 128), f);
                    f32x4 o0, o1;
#pragma unroll
                    for (int j = 0; j < 4; ++j) { o0[j] = acc[ai][bj][m][0][j] * f[j]; o1[j] = acc[ai][bj][m][1][j] * f[4 + j]; }
                    *(f32x4*)(sl + (size_t)row * DM + c0 + bj * 128) = o0; *(f32x4*)(sl + (size_t)row * DM + c0 + bj * 128 + 4) = o1; } }
    }
};
struct FMerge { const bf16* GATES; bf16* MERGED; int br;
    __device__ __forceinline__ void operator()(int row, int col, f32x4 v0, f32x4 v1) const {
        float g[8]; unpack8(*(const u32x4*)(GATES + (size_t)row * 3072 + br * 1024 + col), g);
        float o[8];
#pragma unroll
        for (int j = 0; j < 4; ++j) { o[j] = g[j] * v0[j]; o[4 + j] = g[4 + j] * v1[j]; }
        if (br > 0) { float p[8]; unpack8(*(const u32x4*)(MERGED + (size_t)row * DM + col), p);
#pragma unroll
            for (int j = 0; j < 8; ++j) o[j] += p[j]; }
        u32x4 w; w.x = pk2(o[0], o[1]); w.y = pk2(o[2], o[3]); w.z = pk2(o[4], o[5]); w.w = pk2(o[6], o[7]);
        *(u32x4*)(MERGED + (size_t)row * DM + col) = w;
    } };
struct FKvUp { unsigned char* ws;
    __device__ __forceinline__ void operator()(int row, int col, f32x4 v0, f32x4 v1) const {
        unsigned char* w_ = ws; const float* rss = (const float*)(w_ + WS_STAT);
        const float r = rsqf_(rss[row] * (1.f / 128.f) + EPS);
        const int h = col >> 7, e = col & 127; const size_t boff = (e < 64 ? B_KN : B_V - 128) ;
        bf16* dst = (bf16*)(w_ + boff) + (size_t)row * 512 + h * 64 + e;
        *(u32x4*)dst = pack8(v0 * r, v1 * r);
    } };
struct FQUp { unsigned char* ws;
    __device__ __forceinline__ void operator()(int row, int col, f32x4 v0, f32x4 v1) const {
        unsigned char* w_ = ws; const float* rss = (const float*)(w_ + WS_STAT) + NTOK; const float* rope = (const float*)(w_ + WS_ROPE); bf16* Q = (bf16*)(w_ + B_Q);
        const float r = QSCALE * rsqf_(rss[row] * (1.f / 256.f) + EPS);
        v0 = v0 * r; v1 = v1 * r;
        if (col < 512) { const int h = col >> 6, d = col & 63; *(u32x4*)(Q + (size_t)row * 768 + h * 96 + d) = pack8(v0, v1); }
        else { const int c = col - 512, h = c >> 5, i0 = ((c & 31) >> 3) * 4;
            f32x4 o1 = v0, o2 = v1;
            if (row < NLAT) { const float* cs = rope + ((size_t)(row & 2047) * 16 + i0) * 2;
#pragma unroll
                for (int j = 0; j < 4; ++j) { const float c_ = cs[2 * j], s_ = cs[2 * j + 1]; o1[j] = v0[j] * c_ - v1[j] * s_; o2[j] = v0[j] * s_ + v1[j] * c_; } }
            bf16* q = Q + (size_t)row * 768 + h * 96 + 64 + i0; u32x2 w1, w2; w1.x = pk2(o1[0], o1[1]); w1.y = pk2(o1[2], o1[3]); w2.x = pk2(o2[0], o2[1]); w2.y = pk2(o2[2], o2[3]);
            *(u32x2*)q = w1; *(u32x2*)(q + 16) = w2; }
    } };

struct EpiInA {
    static constexpr bool PERM = true, AFTER_DRAIN = false;
    int row_off; unsigned char* ws; const float* dtb_; int shw_layer;
    __device__ __forceinline__ void operator()(const f32x4 (&acc_)[2][2][4][2], const pg8::Unit& u, int wr, int wc, int fr, int fq) const {
        asm volatile("" : "+v"(fr), "+v"(fq));
        const int pn = u.pn; unsigned char* w_ = ws; const float* dtb = dtb_;
        float pA[8], pB[8]; const int tid_ = (wr * 4 + wc) * 64 + fq * 16 + fr; const int rowt = row_off + u.pm * 256;
#pragma unroll
        for (int i = 0; i < 8; ++i) { pA[i] = 0.f; pB[i] = 0.f; }
        const bool latt = (row_off + u.pm * 256) < NLAT;
        f32x4 shv[2][2]; float rrv[8];
#pragma unroll
        for (int bj = 0; bj < 2; ++bj) { shv[bj][0] = (f32x4){0.f, 0.f, 0.f, 0.f}; shv[bj][1] = (f32x4){0.f, 0.f, 0.f, 0.f}; }
#pragma unroll
        for (int i = 0; i < 8; ++i) rrv[i] = 1.f;
        if (latt) { const float* sp = (const float*)(w_ + WS_SHW) + shw_layer + SHW_INA + (size_t)(u.pm >> 3) * 3072 + pn * 256 + wc * 32 + 8 * fq;
#pragma unroll
            for (int bj = 0; bj < 2; ++bj) { shv[bj][0] = *(const f32x4*)(sp + bj * 128); shv[bj][1] = *(const f32x4*)(sp + bj * 128 + 4); }
            const float* rp = (const float*)(w_ + WS_RSSN) + NLAT + u.pm * 256 + wr * 64 + fr;
#pragma unroll
            for (int i = 0; i < 8; ++i) rrv[i] = rp[(i >> 2) * 128 + (i & 3) * 16];
#pragma unroll
            for (int i = 0; i < 8; ++i) rrv[i] = rsqf_(rrv[i] * (1.f / DM) + EPS); }
        bf16* KVR = (bf16*)(w_ + B_KVR); bf16* KRP = (bf16*)(w_ + B_KRP); bf16* XBCR = (bf16*)(w_ + B_XBCR); bf16* QLAT = (bf16*)(w_ + B_QLAT); bf16* SZ = (bf16*)(w_ + B_SZ); bf16* UV = (bf16*)(w_ + B_UV);
        float* DT = (float*)(w_ + B_DT); float* RSSKV = (float*)(w_ + WS_STAT); float* RSSQ = RSSKV + NTOK; float* VSUM = RSSKV + 2 * NTOK; float* VSQ = RSSKV + 3 * NTOK; const float* rope = (const float*)(w_ + WS_ROPE);
#pragma unroll
        for (int ai = 0; ai < 2; ++ai)
#pragma unroll
            for (int m = 0; m < 4; ++m) {
                const int row = row_off + u.pm * 256 + ai * 128 + wr * 64 + m * 16 + fr;
                const int cw = wc * 32 + 8 * fq;
                const int ai_ = ai, m_ = m;
                f32x4 acc[1][2][1][2];
                { const float r = rrv[ai * 4 + m];
#pragma unroll
                  for (int bj = 0; bj < 2; ++bj)
#pragma unroll
                      for (int n = 0; n < 2; ++n) acc[0][bj][0][n] = acc_[ai][bj][m][n] * r + shv[bj][n]; }
#define ai 0
#define m 0
                if (pn == 0) {
                    const f32x4 v0 = acc[ai][0][m][0], v1 = acc[ai][0][m][1], w0 = acc[ai][1][m][0], w1 = acc[ai][1][m][1];
                    *(u32x4*)(KVR + (size_t)row * 256 + cw) = pack8(v0, v1);
                    *(u32x4*)(KVR + (size_t)row * 256 + 128 + cw) = pack8(w0, w1);
                    float ss = (v0[0] * v0[0] + v0[1] * v0[1]) + (v0[2] * v0[2] + v0[3] * v0[3]) + (v1[0] * v1[0] + v1[1] * v1[1]) + (v1[2] * v1[2] + v1[3] * v1[3]);
                    pA[ai_ * 4 + m_] = sum_fq(ss);
                    if (wc == 0) {
                        f32x4 o1 = w0, o2 = w1; const int i0 = 4 * fq;
                        if (row < NLAT) { const float* cs = rope + ((size_t)(row & 2047) * 16 + i0) * 2;
#pragma unroll
                            for (int j = 0; j < 4; ++j) { const float c_ = cs[2 * j], s_ = cs[2 * j + 1]; o1[j] = w0[j] * c_ - w1[j] * s_; o2[j] = w0[j] * s_ + w1[j] * c_; } }
                        u32x2 a, b; a.x = pk2(o1[0], o1[1]); a.y = pk2(o1[2], o1[3]); b.x = pk2(o2[0], o2[1]); b.y = pk2(o2[2], o2[3]);
                        *(u32x2*)(KRP + (size_t)row * 32 + i0) = a; *(u32x2*)(KRP + (size_t)row * 32 + 16 + i0) = b;
                    } else if (wc == 1 && fq < 2) {
                        f32x4 d0, d1;
#pragma unroll
                        for (int j = 0; j < 4; ++j) { d0[j] = softplusf_(w0[j] + dtb[fq * 8 + j]); d1[j] = softplusf_(w1[j] + dtb[fq * 8 + 4 + j]); }
                        *(f32x4*)(DT + (size_t)row * 16 + fq * 8) = d0; *(f32x4*)(DT + (size_t)row * 16 + fq * 8 + 4) = d1;
                    }
                } else if (pn <= 4) {
#pragma unroll
                    for (int bj = 0; bj < 2; ++bj) *(u32x4*)(XBCR + (size_t)row * 1024 + (pn - 1) * 256 + bj * 128 + cw) = pack8(acc[ai][bj][m][0], acc[ai][bj][m][1]);
                } else if (pn == 5) {
                    float ss = 0.f;
#pragma unroll
                    for (int bj = 0; bj < 2; ++bj) { const f32x4 v0 = acc[ai][bj][m][0], v1 = acc[ai][bj][m][1];
                        *(u32x4*)(QLAT + (size_t)row * 256 + bj * 128 + cw) = pack8(v0, v1);
                        ss += (v0[0] * v0[0] + v0[1] * v0[1]) + (v0[2] * v0[2] + v0[3] * v0[3]) + (v1[0] * v1[0] + v1[1] * v1[1]) + (v1[2] * v1[2] + v1[3] * v1[3]); }
                    pA[ai_ * 4 + m_] = sum_fq(ss);
                } else if (pn <= 7) {
#pragma unroll
                    for (int bj = 0; bj < 2; ++bj) { const f32x4 a0 = silu4(acc[ai][bj][m][0]), a1 = silu4(acc[ai][bj][m][1]);
                        *(u32x4*)(SZ + (size_t)row * 512 + (pn - 6) * 256 + bj * 128 + cw) = pack8(a0, a1); }
                } else {
                    float s = 0.f, ss = 0.f;
#pragma unroll
                    for (int bj = 0; bj < 2; ++bj) { const f32x4 a0 = gelu_tanh4(acc[ai][bj][m][0]), a1 = gelu_tanh4(acc[ai][bj][m][1]);
#pragma unroll
                        for (int j = 0; j < 4; ++j) { s += a0[j] + a1[j]; ss += a0[j] * a0[j] + a1[j] * a1[j]; }
                        *(u32x4*)(UV + (size_t)row * 1024 + (pn - 8) * 256 + bj * 128 + cw) = pack8(a0, a1); }
                    if (pn >= 10) { pA[ai_ * 4 + m_] = sum_fq(s); pB[ai_ * 4 + m_] = sum_fq(ss); }
                }
#undef ai
#undef m
            }
        if (pn == 0) epi_row_atomics(pA, pB, RSSKV + rowt, nullptr, wr, wc, fr, fq, tid_);
        else if (pn == 5) epi_row_atomics(pA, pB, RSSQ + rowt, nullptr, wr, wc, fr, fq, tid_);
        else if (pn >= 10) epi_row_atomics(pA, pB, VSUM + rowt, VSQ + rowt, wr, wc, fr, fq, tid_);
    }
};

typedef __attribute__((address_space(3))) const char* lds_cptr;
typedef short v4i16_t __attribute__((ext_vector_type(4)));
typedef short s16x4 __attribute__((ext_vector_type(4)));
__device__ __forceinline__ s16x4 vtr(lds_cptr p) { return __builtin_bit_cast(s16x4, __builtin_amdgcn_ds_read_tr16_b64_v4i16((__attribute__((address_space(3))) v4i16_t*)p)); }
__device__ __forceinline__ int crow(int r, int hi) { return (r & 3) + 8 * (r >> 2) + 4 * hi; }

#define ATT_THR 8.0f
#define ATT_SLOT 21504
__device__ __forceinline__ void glds16(const void* gsrc, unsigned lds_dst) { unsigned keep;
    asm volatile("s_mov_b32 %0, m0\n\ts_mov_b32 m0, %2\n\ts_nop 0\n\tglobal_load_lds_dwordx4 %1, off\n\ts_mov_b32 m0, %0" : "=&s"(keep) : "v"(gsrc), "s"(lds_dst) : "memory"); }
__device__ __forceinline__ float att_rowmax(const f32x16& p0, const f32x16& p1) {
    float mx = fmaxf(p0[0], p1[0]);
#pragma unroll
    for (int r = 1; r < 16; ++r) mx = fmaxf(fmaxf(mx, p0[r]), p1[r]);
    return max_x32(mx);
}
template <int NB, int VAR = 0> __device__ __forceinline__ void attn_unit(const Frame& F, int h, int qrow0, int seg0_row, int seg0_tiles, int seg1_row, int seg1_tiles, bf16* AOover = nullptr) {
    static_assert(NB == 1, "one 32-row query block per wave");
    const bf16* Q = WSP(bf16, B_Q); bf16* AO = AOover ? AOover : WSP(bf16, B_AMLA);
    int lane = F.lane; asm volatile("" : "+v"(lane));
    const int wid = F.wave, r32 = lane & 31, hi = lane >> 5;
    LAS float* wsf = (LAS float*)(F.lds + 4 * ATT_SLOT) + wid * 128;
    bf16x8 qr[6];
    { const bf16* qp = Q + (size_t)(qrow0 + wid * 32 + r32) * 768 + h * 96 + hi * 8;
#pragma unroll
      for (int d0 = 0; d0 < 6; ++d0) qr[d0] = *(const bf16x8*)(qp + d0 * 16); }
    f32x16 o0 = {}, o1 = {}; float m_run = 0.f, l_run = 0.f;
    const int NT = seg0_tiles + seg1_tiles;
    unsigned dbase[3], dstride[3];
#pragma unroll
    for (int i = 0; i < 3; ++i) { const int j = wid + 8 * i;
        if (j < 13) { const int c = j * 64 + lane, row = c / 13, ch = c - row * 13;
            if (ch < 8) { dbase[i] = (unsigned)B_KN + (unsigned)(row * 512 + h * 64 + ch * 8) * 2u; dstride[i] = 1024u; }
            else if (ch < 12) { dbase[i] = (unsigned)B_KRP + (unsigned)(row * 32 + (ch - 8) * 8) * 2u; dstride[i] = 64u; }
            else { dbase[i] = (unsigned)B_KN + (unsigned)(row * 512) * 2u; dstride[i] = 1024u; } }
        else { const int c = (j - 13) * 64 + lane, dh = (c >> 8) & 1, key = (c >> 2) & 63, q = c & 3; dbase[i] = (unsigned)B_V + (unsigned)(key * 512 + h * 64 + dh * 32 + q * 8) * 2u; dstride[i] = 1024u; } }
    const unsigned char* wsb = WS_BASE; const unsigned lds0 = (unsigned)(uintptr_t)F.lds;
#define ATT_DMA(t_, slot_) do { const int t1_ = (t_); const unsigned rb_ = (unsigned)(t1_ < seg0_tiles ? seg0_row + t1_ * 64 : seg1_row + (t1_ - seg0_tiles) * 64); \
        _Pragma("unroll") for (int i = 0; i < 3; ++i) if (wid + 8 * i < 21) \
            glds16(wsb + (size_t)dbase[i] + (size_t)rb_ * dstride[i], (unsigned)__builtin_amdgcn_readfirstlane((int)(lds0 + (slot_) * ATT_SLOT + (wid + 8 * i) * 1024))); } while (0)
#define ATT_KLD(KT_) const LAS unsigned char* kt_ = (KT_) + r32 * 208 + hi * 16; do { \
        _Pragma("unroll") for (int d0 = 0; d0 < 4; ++d0) { ka[2 * d0] = *(const LAS bf16x8*)(kt_ + d0 * 32); ka[2 * d0 + 1] = *(const LAS bf16x8*)(kt_ + 32 * 208 + d0 * 32); } \
        __builtin_amdgcn_sched_barrier(0); } while (0)
#define ATT_QKM(P0, P1) do { \
        _Pragma("unroll") for (int d0 = 0; d0 < 4; ++d0) { \
            if (d0 == 0) { P0 = __builtin_amdgcn_mfma_f32_32x32x16_bf16(ka[0], qr[0], negm, 0, 0, 0); P1 = __builtin_amdgcn_mfma_f32_32x32x16_bf16(ka[1], qr[0], negm, 0, 0, 0); } \
            else { P0 = __builtin_amdgcn_mfma_f32_32x32x16_bf16(ka[2 * d0], qr[d0], P0, 0, 0, 0); P1 = __builtin_amdgcn_mfma_f32_32x32x16_bf16(ka[2 * d0 + 1], qr[d0], P1, 0, 0, 0); } } \
        _Pragma("unroll") for (int d0 = 4; d0 < 6; ++d0) { const bf16x8 k0_ = *(const LAS bf16x8*)(kt_ + d0 * 32), k1_ = *(const LAS bf16x8*)(kt_ + 32 * 208 + d0 * 32); \
            P0 = __builtin_amdgcn_mfma_f32_32x32x16_bf16(k0_, qr[d0], P0, 0, 0, 0); P1 = __builtin_amdgcn_mfma_f32_32x32x16_bf16(k1_, qr[d0], P1, 0, 0, 0); } } while (0)
    __syncthreads();
    ATT_DMA(0, 0); ATT_DMA(1, 1); ATT_DMA(2, 2);
    if (wid < 5) asm volatile("s_waitcnt vmcnt(3) lgkmcnt(0)" ::: "memory"); else asm volatile("s_waitcnt vmcnt(2) lgkmcnt(0)" ::: "memory");
    __builtin_amdgcn_s_barrier(); asm volatile("" ::: "memory");
    const int vofs = ((lane >> 4) & 1) * 32 + (lane & 3) * 8 + (4 * hi + ((lane & 15) >> 2)) * 64;
    f32x16 negm = {};
    f32x16 pa0, pa1, pb0 = {}, pb1 = {};
    bf16x8 ka[8];
    { ATT_KLD(F.lds); ATT_QKM(pa0, pa1); }
    float mx = att_rowmax(pa0, pa1);
    int sl_cur = 0, sl_nxt = 1, sl_nn = 2, sl_fre = 3;
#define ATT_STEP(PC0, PC1, PN0, PN1, t_) do { const int t = (t_); \
        if (VAR != 4 && VAR != 6 && t + 3 < NT) ATT_DMA(t + 3, sl_fre); \
        if (t == 0 || __any(mx > ATT_THR)) { \
            const float dl = t == 0 ? mx : fmaxf(mx, 0.f), alpha = __builtin_amdgcn_exp2f(-dl); \
            m_run += dl; l_run *= alpha; \
            _Pragma("unroll") for (int r = 0; r < 16; ++r) { PC0[r] -= dl; PC1[r] -= dl; negm[r] = -m_run; } \
            if (hi == 0) wsf[r32] = alpha; \
            asm volatile("s_waitcnt lgkmcnt(0)" ::: "memory"); \
            _Pragma("unroll") for (int q4 = 0; q4 < 4; ++q4) { const f32x4 al = *(const LAS f32x4*)(wsf + 8 * q4 + 4 * hi); \
                _Pragma("unroll") for (int j = 0; j < 4; ++j) { o0[4 * q4 + j] *= al[j]; o1[4 * q4 + j] *= al[j]; } } \
            asm volatile("s_waitcnt lgkmcnt(0)" ::: "memory"); \
        } \
        ATT_KLD(F.lds + sl_nxt * ATT_SLOT); \
        if (VAR != 3 && VAR != 5) ATT_QKM(PN0, PN1); else { asm volatile("" : "+v"(PN0), "+v"(PN1)); } \
        float ps = 0.f; \
        _Pragma("unroll") for (int r = 0; r < 16; ++r) { if (VAR != 2 && VAR != 5) { PC0[r] = __builtin_amdgcn_exp2f(PC0[r]); PC1[r] = __builtin_amdgcn_exp2f(PC1[r]); } ps += PC0[r] + PC1[r]; } \
        l_run += ps; asm volatile("" : "+v"(l_run));     \
        u32x4 pw[4]; \
        pw[0] = (u32x4){pk2(PC0[0], PC0[1]), pk2(PC0[2], PC0[3]), pk2(PC0[4], PC0[5]), pk2(PC0[6], PC0[7])}; \
        pw[1] = (u32x4){pk2(PC0[8], PC0[9]), pk2(PC0[10], PC0[11]), pk2(PC0[12], PC0[13]), pk2(PC0[14], PC0[15])}; \
        pw[2] = (u32x4){pk2(PC1[0], PC1[1]), pk2(PC1[2], PC1[3]), pk2(PC1[4], PC1[5]), pk2(PC1[6], PC1[7])}; \
        pw[3] = (u32x4){pk2(PC1[8], PC1[9]), pk2(PC1[10], PC1[11]), pk2(PC1[12], PC1[13]), pk2(PC1[14], PC1[15])}; \
        _Pragma("unroll") for (int i = 0; i < 12; ++i) { __builtin_amdgcn_sched_group_barrier(0x008, 1, 0); if (i == 3) __builtin_amdgcn_sched_group_barrier(0x100, 4, 0); __builtin_amdgcn_sched_group_barrier(0x002, 7, 0); } \
        __builtin_amdgcn_sched_barrier(0); \
        const lds_cptr vp0 = (lds_cptr)(F.lds + sl_cur * ATT_SLOT + 13312) + vofs; \
        if (VAR != 1 && VAR != 5) { \
            _Pragma("unroll") for (int ks = 0; ks < 4; ++ks) { \
                const s16x4 l0 = vtr(vp0 + ks * 1024), h0 = vtr(vp0 + ks * 1024 + 512), l1 = vtr(vp0 + 4096 + ks * 1024), h1 = vtr(vp0 + 4096 + ks * 1024 + 512); \
                ka[2 * ks] = (bf16x8){l0[0], l0[1], l0[2], l0[3], h0[0], h0[1], h0[2], h0[3]}; ka[2 * ks + 1] = (bf16x8){l1[0], l1[1], l1[2], l1[3], h1[0], h1[1], h1[2], h1[3]}; } \
            __builtin_amdgcn_sched_barrier(0); \
            _Pragma("unroll") for (int ks = 0; ks < 4; ++ks) { \
                const bf16x8 pa = __builtin_bit_cast(bf16x8, pw[ks]); \
                o0 = __builtin_amdgcn_mfma_f32_32x32x16_bf16(pa, ka[2 * ks], o0, 0, 0, 0); \
                o1 = __builtin_amdgcn_mfma_f32_32x32x16_bf16(pa, ka[2 * ks + 1], o1, 0, 0, 0); } } \
        else { asm volatile("" :: "v"(pw[0]), "v"(pw[1]), "v"(pw[2]), "v"(pw[3])); } \
        mx = att_rowmax(PN0, PN1); \
        _Pragma("unroll") for (int i = 0; i < 8; ++i) { __builtin_amdgcn_sched_group_barrier(0x008, 1, 0); __builtin_amdgcn_sched_group_barrier(0x002, 3, 0); } \
        { const int tmp = sl_cur; sl_cur = sl_nxt; sl_nxt = sl_nn; sl_nn = sl_fre; sl_fre = tmp; } \
        if (t + 3 < NT) { if (wid < 5) asm volatile("s_waitcnt vmcnt(3) lgkmcnt(0)" ::: "memory"); else asm volatile("s_waitcnt vmcnt(2) lgkmcnt(0)" ::: "memory"); } \
        else asm volatile("s_waitcnt vmcnt(0) lgkmcnt(0)" ::: "memory"); \
        if (VAR != 6) __builtin_amdgcn_s_barrier(); asm volatile("" ::: "memory"); } while (0)
    for (int t2 = 0; t2 < NT; t2 += 2) {
        ATT_STEP(pa0, pa1, pb0, pb1, t2);
        ATT_STEP(pb0, pb1, pa0, pa1, t2 + 1);
    }
#undef ATT_STEP
    {
        float lt = sum_x32(l_run);
        if (hi == 0) wsf[32 + r32] = __builtin_amdgcn_rcpf(lt);
        asm volatile("s_waitcnt lgkmcnt(0)" ::: "memory");
        bf16* ao = AO + (size_t)(qrow0 + wid * 32) * 512 + h * 64 + r32;
#pragma unroll
        for (int q4 = 0; q4 < 4; ++q4) { const f32x4 il = *(const LAS f32x4*)(wsf + 32 + 8 * q4 + 4 * hi);
#pragma unroll
            for (int j = 0; j < 4; ++j) { const int r = 4 * q4 + j, qq = crow(r, hi); ao[(size_t)qq * 512] = f2bf(o0[r] * il[j]); ao[(size_t)qq * 512 + 32] = f2bf(o1[r] * il[j]); } }
        asm volatile("s_waitcnt lgkmcnt(0)" ::: "memory");
    }
#undef ATT_DMA
#undef ATT_KLD
#undef ATT_QKM
}

__device__ __forceinline__ f32x4 mfma16(bf16x8 a, bf16x8 b, f32x4 c) { return __builtin_amdgcn_mfma_f32_16x16x32_bf16(a, b, c, 0, 0, 0); }
__device__ __forceinline__ bf16x8 trpair(lds_cptr lo, lds_cptr hi) { const s16x4 a = vtr(lo), b = vtr(hi); return (bf16x8){a[0], a[1], a[2], a[3], b[0], b[1], b[2], b[3]}; }
template <int VAR = 0> __device__ __forceinline__ void ssd_unit(const Frame& F, int l, int b, int dir, int h, bool ctx_y, bf16* Yover = nullptr) {
    const bf16* XBC = WSP(bf16, B_XBC); const float* DT = WSP(float, B_DT); bf16* Y = Yover ? Yover : (dir == 0 ? WSP(bf16, B_YF) : WSP(bf16, B_YB));
    int tid = F.tid; asm volatile("" : "+v"(tid));
    const int lane = tid & 63, wid = F.wave, l15 = lane & 15, g4 = lane >> 4, grp = h >> 2;
    constexpr int P = 136, PX = 72;
    unsigned oB = 34816, oX = 69632, oW = 88064, oH = 106496, oA = 123904, oY = 126464;
    asm volatile("" : "+s"(oB), "+s"(oX), "+s"(oW), "+s"(oH), "+s"(oA), "+s"(oY));
    LAS bf16* CS = (LAS bf16*)(F.lds); LAS bf16* BS = (LAS bf16*)(F.lds + oB); LAS bf16* XS = (LAS bf16*)(F.lds + oX); LAS bf16* XW = (LAS bf16*)(F.lds + oW); LAS bf16* HS = (LAS bf16*)(F.lds + oH);
    LAS float* ACU = (LAS float*)(F.lds + oA); LAS float* DTV = ACU + 128; LAS float* WQ = ACU + 256; LAS float* ATOT = ACU + 384; LAS float* FJ = ACU + 512;
    LAS bf16* YST = (LAS bf16*)(F.lds + oY) + wid * (16 * PX);
    const float Acoef = -__expf(INP(I_ALOG)[(l * 2 + dir) * 8 + h]); const float Dd = dir == 0 ? INP(I_SSMD)[l * 8 + h] : 0.f;
    const int rt = wid < 4 ? wid : 11 - wid;
    const int refo = dir ? 0 : 15;
    f32x4 hst[4];
#pragma unroll
    for (int pt = 0; pt < 4; ++pt) hst[pt] = (f32x4){0.f, 0.f, 0.f, 0.f};
    __syncthreads();
    for (int i = tid; i < 64 * P / 2; i += NTHR) ((LAS unsigned*)HS)[i] = 0u;
    const int trq = (lane & 15) >> 2, trp = (lane & 3) * 4;
    const int crow_ = tid >> 4, cch = tid & 15;
    const int xq = tid >> 3, xch = tid & 7;
    u32x4 c_r[4], b_r[4], x_r[2]; float d_r0 = 0.f, d_r1 = 0.f;
#define SSD_ROW0(step_) (((step_) < 2) ? NLAT + b * CTXL + (dir == 0 ? (step_) : 1 - (step_)) * 128 : b * SEQ + (dir == 0 ? (step_) - 2 : 17 - (step_)) * 128)
#define SSD_LOAD(step_) do { const int R_ = SSD_ROW0(step_); \
        _Pragma("unroll") for (int i = 0; i < 4; ++i) { const size_t ro = (size_t)(R_ + crow_ + 32 * i) * 1024 + grp * 128 + cch * 8; c_r[i] = *(const u32x4*)(XBC + ro + 768); b_r[i] = *(const u32x4*)(XBC + ro + 512); } \
        _Pragma("unroll") for (int i = 0; i < 2; ++i) x_r[i] = *(const u32x4*)(XBC + (size_t)(R_ + xq + 64 * i) * 1024 + h * 64 + xch * 8); \
        if (wid == 0) { const int q0 = dir ? 127 - 2 * lane : 2 * lane, q1 = dir ? 126 - 2 * lane : 2 * lane + 1; d_r0 = DT[(size_t)(R_ + q0) * 16 + dir * 8 + h]; d_r1 = DT[(size_t)(R_ + q1) * 16 + dir * 8 + h]; } } while (0)
    SSD_LOAD(0);
    for (int step = 0; step < 18; ++step) {
        const bool isctx = step < 2; const int R0 = SSD_ROW0(step);
        const bool need_y = (VAR != 1) && (!isctx || ctx_y);
#pragma unroll
        for (int i = 0; i < 4; ++i) { *(LAS u32x4*)(CS + (crow_ + 32 * i) * P + cch * 8) = c_r[i]; *(LAS u32x4*)(BS + (crow_ + 32 * i) * P + cch * 8) = b_r[i]; }
#pragma unroll
        for (int i = 0; i < 2; ++i) *(LAS u32x4*)(XS + (xq + 64 * i) * PX + xch * 8) = x_r[i];
        if (wid == 0) {
            const int q0 = dir ? 127 - 2 * lane : 2 * lane, q1 = dir ? 126 - 2 * lane : 2 * lane + 1;
            const float a0 = d_r0 * Acoef, a1 = d_r1 * Acoef, sm = a0 + a1; float incl = sm;
#pragma unroll
            for (int off = 1; off < 64; off <<= 1) { const float t = __shfl_up(incl, off); if (lane >= off) incl += t; }
            const float excl = incl - sm, c0 = excl + a0, c1 = incl, atot = __shfl(incl, 63);
            ACU[q0] = c0; ACU[q1] = c1; DTV[q0] = d_r0; DTV[q1] = d_r1; WQ[q0] = __expf(atot - c0) * d_r0; WQ[q1] = __expf(atot - c1) * d_r1;
            if (lane == 0) ATOT[0] = atot;
            asm volatile("s_waitcnt lgkmcnt(0)" ::: "memory");
            FJ[q0] = __expf(ACU[(q0 & ~15) + refo] - c0) * d_r0; FJ[q1] = __expf(ACU[(q1 & ~15) + refo] - c1) * d_r1;
        }
        __syncthreads();
#pragma unroll
        for (int i = 0; i < 2; ++i) { float f[8]; unpack8(x_r[i], f); const float wq = WQ[xq + 64 * i];
            u32x4 o; o.x = pk2(f[0] * wq, f[1] * wq); o.y = pk2(f[2] * wq, f[3] * wq); o.z = pk2(f[4] * wq, f[5] * wq); o.w = pk2(f[6] * wq, f[7] * wq);
            *(LAS u32x4*)(XW + (xq + 64 * i) * PX + xch * 8) = o; }
        if (step + 1 < 18 && VAR != 3) SSD_LOAD(step + 1);
        bf16x8 cfr[4];
#pragma unroll
        for (int kk = 0; kk < 4; ++kk) cfr[kk] = *(const LAS bf16x8*)(CS + (16 * rt + l15) * P + kk * 32 + g4 * 8);
        if (need_y) {
            f32x4 T[8];
#pragma unroll
            for (int jt = 0; jt < 8; ++jt) { f32x4 a = (f32x4){0.f, 0.f, 0.f, 0.f};
                if (dir == 0 ? (jt <= rt) : (jt >= rt)) {
#pragma unroll
                for (int kk = 0; kk < 4; ++kk) { const bf16x8 bb = *(const LAS bf16x8*)(BS + (16 * jt + l15) * P + kk * 32 + g4 * 8); a = mfma16(bb, cfr[kk], a); } }
                T[jt] = a; }
            int ii = 16 * rt + l15, jb = 4 * g4; asm volatile("" : "+v"(ii), "+v"(jb));
            const float ai = ACU[ii];
            bf16x8 sfr[4];
#pragma unroll
            for (int m = 0; m < 4; ++m) { u32x4 pk;
#pragma unroll
                for (int hh = 0; hh < 2; ++hh) { const int jt = 2 * m + hh; float sv[4] = {0.f, 0.f, 0.f, 0.f};
                    if (dir == 0 ? (jt <= rt) : (jt >= rt)) { const f32x4 fj = *(const LAS f32x4*)(FJ + 16 * jt + jb); const float ei = __expf(ai - ACU[16 * jt + refo]);
#pragma unroll
                    for (int r = 0; r < 4; ++r) { const int j = 16 * jt + jb + r; const bool valid = dir == 0 ? (j <= ii) : (j >= ii); sv[r] = valid ? T[jt][r] * ei * fj[r] : 0.f; } }
                    if (hh == 0) { pk.x = pk2(sv[0], sv[1]); pk.y = pk2(sv[2], sv[3]); } else { pk.z = pk2(sv[0], sv[1]); pk.w = pk2(sv[2], sv[3]); } }
                sfr[m] = __builtin_bit_cast(bf16x8, pk); }
            f32x4 ee = *(const LAS f32x4*)(ACU + 16 * rt + 4 * g4);
#pragma unroll
            for (int r = 0; r < 4; ++r) ee[r] = __expf(ee[r]);
#pragma unroll
            for (int pt = 0; pt < 4; ++pt) { f32x4 yi = (f32x4){0.f, 0.f, 0.f, 0.f}, ye = (f32x4){0.f, 0.f, 0.f, 0.f};
#pragma unroll
                for (int m = 0; m < 4; ++m) { if (dir == 0 ? (2 * m <= rt) : (2 * m + 1 >= rt)) { const lds_cptr xb = (lds_cptr)(XS + (32 * m + 4 * g4 + trq) * PX + 16 * pt + trp); yi = mfma16(sfr[m], trpair(xb, xb + 16 * PX * 2), yi); } }
#pragma unroll
                for (int kk = 0; kk < 4; ++kk) { const bf16x8 bh = *(const LAS bf16x8*)(HS + (16 * pt + l15) * P + kk * 32 + g4 * 8); ye = mfma16(cfr[kk], bh, ye); }
                const s16x4 xd = vtr((lds_cptr)(XS + (16 * rt + 4 * g4 + trq) * PX + 16 * pt + trp));
#pragma unroll
                for (int r = 0; r < 4; ++r) YST[(4 * g4 + r) * PX + 16 * pt + l15] = f2bf(yi[r] + ee[r] * ye[r] + Dd * bf2f((bf16)xd[r])); }
            asm volatile("s_waitcnt lgkmcnt(0)" ::: "memory");
            { const int yr = lane >> 2, yc = lane & 3;
#pragma unroll
              for (int k = 0; k < 2; ++k) { const u32x4 v = *(const LAS u32x4*)(YST + yr * PX + (yc + 4 * k) * 8); if (VAR != 4) *(u32x4*)(Y + (size_t)(R0 + 16 * rt + yr) * 512 + h * 64 + (yc + 4 * k) * 8) = v; else asm volatile("" :: "v"(v)); } }
        }
        __syncthreads();
        if (VAR != 2) {
            const float decay = __expf(ATOT[0]);
            bf16x8 bq[4];
#pragma unroll
            for (int kk = 0; kk < 4; ++kk) { const lds_cptr bb = (lds_cptr)(BS + (32 * kk + 8 * g4 + trq) * P + 16 * wid + trp); bq[kk] = trpair(bb, bb + 4 * P * 2); }
#pragma unroll
            for (int pt = 0; pt < 4; ++pt) { f32x4 a = hst[pt] * decay;
#pragma unroll
                for (int kk = 0; kk < 4; ++kk) { const lds_cptr xb = (lds_cptr)(XW + (32 * kk + 8 * g4 + trq) * PX + 16 * pt + trp); a = mfma16(trpair(xb, xb + 4 * PX * 2), bq[kk], a); }
                hst[pt] = a;
#pragma unroll
                for (int r = 0; r < 4; ++r) HS[(16 * pt + 4 * g4 + r) * P + 16 * wid + l15] = f2bf(a[r]); }
        }
        __syncthreads();
    }
#undef SSD_ROW0
#undef SSD_LOAD
}

__device__ __forceinline__ void gmlp_unit(const Frame& F, int l, int R0, int g) {
    constexpr int PV = 72, PO = 68;
    LAS bf16* VN = (LAS bf16*)(F.lds);
    const bf16* UV = WSP(bf16, B_UV); bf16* GM = WSP(bf16, B_GM); const float* VSUM = WSP(float, WS_STAT) + 2 * NTOK; const float* VSQ = WSP(float, WS_STAT) + 3 * NTOK;
    const bf16* Wg = WGT(W_GS) + (size_t)g * 128 * 128; const float* gn = INP(I_GMNORM) + l * 512 + g * 64; const float* bs = INP(I_GMBS) + (l * 8 + g) * 128;
    int tid = F.tid; asm volatile("" : "+v"(tid));
    const int lane = tid & 63, wid = F.wave, l15 = lane & 15, l4 = lane >> 4, trq = (lane & 15) >> 2, trp = (lane & 3) * 4;
    LAS float* OST = (LAS float*)(F.lds + 18432) + wid * (16 * PO);
    bf16x8 a[4];
#pragma unroll
    for (int kk = 0; kk < 4; ++kk) a[kk] = *(const bf16x8*)(Wg + (16 * wid + l15) * 128 + kk * 32 + l4 * 8);
    __syncthreads();
#pragma unroll
    for (int i = 0; i < 2; ++i) { const int piece = tid + NTHR * i, j = piece >> 3, ch = piece & 7;
        const u32x4 vv = *(const u32x4*)(UV + (size_t)(R0 + j) * 1024 + 512 + g * 64 + ch * 8); float f[8]; unpack8(vv, f);
        const float mean = VSUM[R0 + j] * (1.f / 512.f); const float var = fmaxf(VSQ[R0 + j] * (1.f / 512.f) - mean * mean, 0.f); const float rstd = rsqf_(var + EPS);
        const f32x4 g0 = *(const f32x4*)(gn + ch * 8), g1 = *(const f32x4*)(gn + ch * 8 + 4);
        u32x4 o; o.x = pk2((f[0] - mean) * rstd * g0[0], (f[1] - mean) * rstd * g0[1]); o.y = pk2((f[2] - mean) * rstd * g0[2], (f[3] - mean) * rstd * g0[3]);
        o.z = pk2((f[4] - mean) * rstd * g1[0], (f[5] - mean) * rstd * g1[1]); o.w = pk2((f[6] - mean) * rstd * g1[2], (f[7] - mean) * rstd * g1[3]);
        *(LAS u32x4*)(VN + j * PV + ch * 8) = o; }
    __syncthreads();
    const f32x4 bi = *(const f32x4*)(bs + 16 * wid + 4 * l4);
#pragma unroll
    for (int dt = 0; dt < 4; ++dt) { f32x4 acc = (f32x4){0.f, 0.f, 0.f, 0.f};
#pragma unroll
        for (int kk = 0; kk < 4; ++kk) { const lds_cptr vb = (lds_cptr)(VN + (32 * kk + 8 * l4 + trq) * PV + 16 * dt + trp); acc = mfma16(a[kk], trpair(vb, vb + 4 * PV * 2), acc); }
#pragma unroll
        for (int r = 0; r < 4; ++r) OST[(4 * l4 + r) * PO + 16 * dt + l15] = acc[r] + bi[r]; }
    asm volatile("s_waitcnt lgkmcnt(0)" ::: "memory");
    { const int yr = lane >> 2, yc = (lane & 3) * 16; const size_t rowg = (size_t)(R0 + 16 * wid + yr);
      float uu[16]; unpack8(*(const u32x4*)(UV + rowg * 1024 + g * 64 + yc), uu); unpack8(*(const u32x4*)(UV + rowg * 1024 + g * 64 + yc + 8), uu + 8);
      f32x4 mx[4];
#pragma unroll
      for (int k = 0; k < 4; ++k) mx[k] = *(const LAS f32x4*)(OST + yr * PO + yc + 4 * k);
      u32x4 o0, o1;
      o0.x = pk2(uu[0] * mx[0][0], uu[1] * mx[0][1]); o0.y = pk2(uu[2] * mx[0][2], uu[3] * mx[0][3]); o0.z = pk2(uu[4] * mx[1][0], uu[5] * mx[1][1]); o0.w = pk2(uu[6] * mx[1][2], uu[7] * mx[1][3]);
      o1.x = pk2(uu[8] * mx[2][0], uu[9] * mx[2][1]); o1.y = pk2(uu[10] * mx[2][2], uu[11] * mx[2][3]); o1.z = pk2(uu[12] * mx[3][0], uu[13] * mx[3][1]); o1.w = pk2(uu[14] * mx[3][2], uu[15] * mx[3][3]);
      *(u32x4*)(GM + rowg * 512 + g * 64 + yc) = o0; *(u32x4*)(GM + rowg * 512 + g * 64 + yc + 8) = o1; }
}

constexpr int PH_PER_LAYER = 13, N_PHASES = 1 + 2 * PH_PER_LAYER + 1;

__global__ void __launch_bounds__(NTHR, 2) mk_fwd(Args args) {
    extern __shared__ __attribute__((aligned(16))) unsigned char lds_raw[];
    Frame F;
    F.lds = (LAS unsigned char*)lds_raw;
    F.tid = threadIdx.x; F.lane = F.tid & 63; F.wave = __builtin_amdgcn_readfirstlane(F.tid >> 6);
    F.G = gridDim.x; F.bid = blockIdx.x; F.vcu = F.bid; F.z = 0;
    F.ka = (const __attribute__((address_space(4))) char*)__builtin_amdgcn_kernarg_segment_ptr();
    volatile LAS unsigned* MISC = (volatile LAS unsigned*)(F.lds + MISC_OFF);
    if (F.tid < 64) MISC[F.tid] = 0u;
    __syncthreads();
    unsigned* ctl = WSP(unsigned, WS_CTL);
    XcdBarrier bar; bar.bar = ctl + CW_BAR; bar.x = 0; bar.st = nullptr;
#if !MK_PER_PHASE
    bar = xcd_barrier_post(ctl + CW_BAR, MISC + 8);
#endif
    const int lo = args.ph_lo, hi = args.ph_hi;
#define TID0() (F.wave == 0 && __builtin_amdgcn_mbcnt_hi(~0u, __builtin_amdgcn_mbcnt_lo(~0u, 0u)) == 0u)
    if (PROBING && blockIdx.x == 0 && TID0()) ((unsigned long long*)(ctl + CW_TS))[0] = __builtin_amdgcn_s_memrealtime();
#ifndef PHMASK
#define PHMASK 0xFFFFu
#endif
#define IN(k) (lo <= (k) && (k) < hi)
#define PM(i) (((PHMASK) >> (i)) & 1u)
#define PHASE_BEGIN() do { F.z = 0; asm volatile("" : "+s"(F.z)); asm volatile("" : "+s"(F.ka)); asm volatile("" : "+s"(lq)); F.lane = (int)__builtin_amdgcn_mbcnt_hi(~0u, __builtin_amdgcn_mbcnt_lo(~0u, 0u)); F.tid = (F.wave << 6) | F.lane; asm volatile("" : "+v"(F.tid)); F.lane = F.tid & 63; \
        F.G = (int)gridDim.x + (int)F.z; F.bid = (int)blockIdx.x + (int)F.z; F.vcu = (F.G % 8 == 0) ? (F.bid % 8) * (F.G / 8) + F.bid / 8 : F.bid; } while (0)
#ifndef MXMASK
#define MXMASK 0xFFu
#endif
#define MX(i) (((MXMASK) >> (i)) & 1u)
#if MK_PER_PHASE
#define SEAM(k) do {} while (0)
#else
#define MIDSEAM() xcd_barrier(bar, F.wave)
#define SEAM(k) do { if (IN(k) && IN((k) + 1)) xcd_barrier(bar, F.wave); if (PROBING && blockIdx.x == 0 && TID0()) ((unsigned long long*)(ctl + CW_TS))[(k) + 1] = __builtin_amdgcn_s_memrealtime(); } while (0)
#endif
    LAS unsigned char* glds = F.lds;
    const float* MOD = WSP(float, WS_MOD);

    int lq = 0;
    if (PM(13) && IN(0)) { PHASE_BEGIN(); prologue_mod(F); __syncthreads();
        { float* shz = WSP(float, WS_SHW); for (int i = F.bid * NTHR + F.tid; i < 2 * (int)SHW_LAYER; i += F.G * NTHR) shz[i] = 0.f; }
#pragma clang loop unroll(disable)
        for (int set = 0; set < 4; ++set) convert_set(F, 0, set, F.vcu, F.G, WGT(W_F2I)); }
    SEAM(0);
#pragma clang loop unroll(disable)
    for (int l = 0; l < 2; ++l) {
        const int pb = 1 + PH_PER_LAYER * l; const bool last = (l == 1); int lq = l;
#define modl (MOD + (size_t)lq * 9 * MODW)
        if (PM(0) && IN(pb + 0)) { PHASE_BEGIN(); if (lq > 0) { norm_phase(F, lq, 0, false, false, NLAT, NTOK, 4, WSP(bf16, WS_H)); zero_rssn(F, 1, 1); }
            else { norm_phase(F, lq, 0, true, true, 0, NTOK, 0, WSP(bf16, WS_H)); shw_phase(F); zero_rssn(F, 0, 3); } }
        SEAM(pb + 0);
#if PROBE_CVT >= 0
        if (lq > 0) { PHASE_BEGIN();
            if (blockIdx.x == 0 && TID0()) ((unsigned long long*)(ctl + CW_TS))[56] = __builtin_amdgcn_s_memrealtime();
            if (PROBE_CVT == 0) { for (int set = 0; set < 4; ++set) convert_set(F, lq, set, F.vcu, F.G, F2ALT); } else norm_phase(F, lq, 0, false, false, NLAT, NTOK, 0, WSP(bf16, WS_H));
            xcd_barrier(bar, F.wave);
            if (blockIdx.x == 0 && TID0()) ((unsigned long long*)(ctl + CW_TS))[57] = __builtin_amdgcn_s_memrealtime();
        }
#endif
        if (PM(1) && IN(pb + 1)) { PHASE_BEGIN(); pg8::Gemm g{WSP(bf16, WS_H), WGT(W_F1I), NTOK, 2 * DFF, DM, DM, DM}; pg8::StaticOrder S; S.init(NTOK, 2 * DFF, F.G, F.bid);
            EpiSwiglu E{WSP(bf16, B_ACT), WSP(float, WS_RSSN), WSP(float, WS_SHW) + (size_t)lq * SHW_LAYER + SHW_F1, lq > 0 ? 1 : 0}; pg8::gemm_phase<EpiSwiglu, pg8::StaticOrder, true, true>(glds, g, S, E, F.tid);
            if (lq == 0) tail_convert(F, S.nwg, 0); }
        SEAM(pb + 1);
        if (PM(2) && IN(pb + 2)) { PHASE_BEGIN();
#pragma clang loop unroll(disable)
            for (int pass = 0; pass < 2; ++pass) {
            if ((pass == 1) == (F.bid < 128)) {
            { pg8::Gemm g{WSP(bf16, B_ACT), WGT(W_F1O), NLAT, DM, DFF, DFF, DFF}; pg8::StaticOrder S; S.init(NLAT, DM, F.G, F.bid);
              EpiResidN E{XBP, modl, modl, INP(I_NORMG) + (lq * 3 + 1) * DM, WSP(float, WS_RSSN) + NLAT, WSP(bf16, WS_H), 2, 1, 0.5f}; pg8::gemm_phase<EpiResidN, pg8::StaticOrder, true, true>(glds, g, S, E, F.tid); }
            } else {
            { pg8::Gemm g{WSP(bf16, B_ACT) + (size_t)NLAT * DFF, WGT(W_F1O), NCTX, DM, 768, DFF, DFF}; pg8::SliceOrder S; S.init(NCTX, DM, 2, F.G, F.bid);
              EpiSlab E{WSP(float, B_SLAB), modl, 2, 0, 0.5f}; pg8::gemm_phase<EpiSlab, pg8::SliceOrder, true, true>(glds, g, S, E, F.tid); }
            { pg8::Gemm g{WSP(bf16, B_ACT) + (size_t)NLAT * DFF + 1536, WGT(W_F1O) + 1536, NCTX, DM, 640, DFF, DFF}; pg8::SliceOrder S; S.init(NCTX, DM, 2, F.G, (F.bid + F.G - 64) % F.G);
              EpiSlab E{WSP(float, B_SLAB), modl, 2, 2, 0.5f}; pg8::gemm_phase<EpiSlab, pg8::SliceOrder, true, true>(glds, g, S, E, F.tid); }
            } }
        }
        SEAM(pb + 2);
        if (PM(3) && IN(pb + 3)) { PHASE_BEGIN(); norm_phase(F, lq, 1, false, lq == 0, NLAT, NTOK, 4, WSP(bf16, WS_H)); zero_stats(F); zero_rssn(F, 2, 1); }
        SEAM(pb + 3);
        if (PM(4) && IN(pb + 4)) { PHASE_BEGIN();
            EpiInA E{0, WS_BASE, INP(I_DTBIAS) + lq * 16, (int)(lq * SHW_LAYER)};
            if (!last) { pg8::Gemm g{WSP(bf16, WS_H), WGT(W_INA), NTOK, 3072, DM, DM, DM}; pg8::StaticOrder S; S.init(NTOK, 3072, F.G, F.bid); pg8::gemm_phase<EpiInA, pg8::StaticOrder, true, true>(glds, g, S, E, F.tid);
                         if (lq == 0) tail_convert(F, S.nwg, 1); }
            else { { pg8::Gemm g{WSP(bf16, WS_H), WGT(W_INA), NLAT, 3072, DM, DM, DM}; pg8::StaticOrder S; S.init(NLAT, 3072, F.G, F.bid); pg8::gemm_phase<EpiInA, pg8::StaticOrder, true, true>(glds, g, S, E, F.tid); }
                   { E.row_off = NLAT; pg8::Gemm g{WSP(bf16, WS_H) + (size_t)NLAT * DM, WGT(W_INA), NCTX, 1280, DM, DM, DM}; pg8::StaticOrder S; S.init(NCTX, 1280, F.G, (int)((F.bid + 128) % F.G)); pg8::gemm_phase<EpiInA, pg8::StaticOrder, true, true>(glds, g, S, E, F.tid); } }
        }
        SEAM(pb + 4);
        if (PM(5) && IN(pb + 5)) { PHASE_BEGIN();
            if (MX(3)) { pg8::Gemm g{WSP(bf16, B_KVR), WGT(W_UKV), NTOK, 1024, 256, 256, 256}; pg8::StaticOrder S; S.init(NTOK, 1024, F.G, F.bid);
              pg8::Epi8<FKvUp> E{FKvUp{WS_BASE}}; pg8::gemm_phase<pg8::Epi8<FKvUp>, pg8::StaticOrder, true, true>(glds, g, S, E, F.tid); }
            if (MX(4)) { const int M = last ? NLAT : NTOK; pg8::Gemm g{WSP(bf16, B_QLAT), WGT(W_UQ), M, 768, 256, 256, 256}; pg8::StaticOrder S; S.init(M, 768, F.G, (int)((F.bid + 32) % F.G));
              pg8::Epi8<FQUp> E{FQUp{WS_BASE}}; pg8::gemm_phase<pg8::Epi8<FQUp>, pg8::StaticOrder, true, true>(glds, g, S, E, F.tid); }
            if (MX(5)) conv_phase(F, lq, NTOK);
        }
        SEAM(pb + 5);
        if (PM(6) && IN(pb + 6)) { PHASE_BEGIN();
            const int nssd = 128, natt = 512 + (last ? 0 : 64), ngm = 256 + (last ? 0 : 32), ntot = nssd + natt + ngm;
            unsigned* head = ctl + CW_QUEUE + 64 * lq;
            for (;;) {
                __syncthreads();
                if (F.tid == 0) MISC[0] = __hip_atomic_fetch_add(head, 1u, __ATOMIC_RELAXED, __HIP_MEMORY_SCOPE_AGENT);
                __syncthreads();
                int u = (int)MISC[0];
                if (u >= ntot) break;
                const int u0_ = u;
                if (u < nssd) { if (MX(0)) ssd_unit(F, lq, u >> 4, (u >> 3) & 1, u & 7, !last); }
                else if (u < nssd + natt) { u -= nssd;
                    if (u < 512) { const int b = u >> 6, h = (u >> 3) & 7, qb = u & 7; if (MX(1)) attn_unit<1>(F, h, b * SEQ + qb * 256, b * SEQ, 32, NLAT + b * CTXL, 4); }
                    else { u -= 512; const int b = u >> 3, h = u & 7; if (MX(1)) attn_unit<1>(F, h, NLAT + b * CTXL, NLAT + b * CTXL, 4, 0, 0); } }
                else { u -= nssd + natt;
                    int R0g, g0;
                    if (u < 256) { const int b = u >> 5, c = (u >> 1) & 15; R0g = b * SEQ + c * 128; g0 = (u & 1) * 4; }
                    else { u -= 256; const int b = u >> 2, c = (u >> 1) & 1; R0g = NLAT + b * CTXL + c * 128; g0 = (u & 1) * 4; }
                    if (MX(2)) { for (int gg = 0; gg < 4; ++gg) gmlp_unit(F, lq, R0g, g0 + gg); } }
                if (PROBING && !last && F.tid == 0) { const int k_ = u0_ < nssd ? 40 : (u0_ < nssd + natt ? 41 : 42); atomicMax((unsigned long long*)(ctl + CW_TS) + k_, (unsigned long long)__builtin_amdgcn_s_memrealtime()); }
            }
        }
        SEAM(pb + 6);
#if PROBE_ATTV >= 0
        if (lq == 0) { PHASE_BEGIN();
            if (blockIdx.x == 0 && TID0()) ((unsigned long long*)(ctl + CW_TS))[54] = __builtin_amdgcn_s_memrealtime();
            for (int u = F.bid; u < 512; u += F.G) { const int b = u >> 6, h = (u >> 3) & 7, qb = u & 7; attn_unit<1, PROBE_ATTV>(F, h, b * SEQ + qb * 256, b * SEQ, 32, NLAT + b * CTXL, 4, WSP(bf16, B_UV)); }
            xcd_barrier(bar, F.wave);
            if (blockIdx.x == 0 && TID0()) ((unsigned long long*)(ctl + CW_TS))[55] = __builtin_amdgcn_s_memrealtime();
        }
#endif
#if PROBE_SSDV >= 0
        if (lq == 0) { PHASE_BEGIN();
            if (blockIdx.x == 0 && TID0()) ((unsigned long long*)(ctl + CW_TS))[52] = __builtin_amdgcn_s_memrealtime();
            if (F.bid < 128) ssd_unit<PROBE_SSDV>(F, lq, F.bid >> 4, (F.bid >> 3) & 1, F.bid & 7, true, WSP(bf16, B_Q));
            xcd_barrier(bar, F.wave);
            if (blockIdx.x == 0 && TID0()) ((unsigned long long*)(ctl + CW_TS))[53] = __builtin_amdgcn_s_memrealtime();
        }
#endif
        const int MR = last ? NLAT : NTOK;
        if (PM(7) && IN(pb + 7)) { PHASE_BEGIN();
            ssm_out_prep(F, lq, MR);
            pg8::Gemm g{WSP(bf16, WS_H), WGT(W_GATE), MR, 3072, DM, DM, DM}; pg8::StaticOrder S; S.init(MR, 3072, F.G, F.bid);
            EpiGates E{WSP(bf16, B_GATES), INP(I_BGATE) + lq * 3072, WSP(float, WS_RSSN) + NLAT, WSP(float, WS_SHW) + (size_t)lq * SHW_LAYER + SHW_GATE}; pg8::gemm_phase<EpiGates, pg8::StaticOrder, true, true>(glds, g, S, E, F.tid);
            if (lq == 0) tail_convert(F, S.nwg, 2);
        }
        SEAM(pb + 7);
        if (PM(8) && IN(pb + 8)) { PHASE_BEGIN();
            { pg8::ChainOrder S; S.init(NLAT, DM, F.G, F.bid);
              pg8::Gemm g{WSP(bf16, B_AMLA), WGT(W_MO), NLAT, DM, 512, 512, 512, WSP(bf16, B_YF), WSP(bf16, B_GM), WGT(W_SO), WGT(W_GO)};
              EpiMergeChain E{WSP(bf16, B_GATES), WSP(bf16, WS_H)}; pg8::gemm_phase<EpiMergeChain, pg8::ChainOrder, true, true>(glds, g, S, E, F.tid); }
            if (!last) {
              { pg8::BranchOrder S; S.init(NCTX, DM, F.G, F.bid);
                pg8::Gemm g{WSP(bf16, B_AMLA) + (size_t)NLAT * 512, WGT(W_MO), NCTX, DM, 512, 512, 512, WSP(bf16, B_YF) + (size_t)NLAT * 512, WSP(bf16, B_GM) + (size_t)NLAT * 512, WGT(W_SO), WGT(W_GO)};
                EpiMergeSlab E{WSP(bf16, B_GATES), WSP(float, B_MSLAB)}; pg8::gemm_phase<EpiMergeSlab, pg8::BranchOrder, true, true>(glds, g, S, E, F.tid); }
              MIDSEAM();
              merge_ctx_sum(F);
            }
        }
        SEAM(pb + 8);
        if (PM(9) && IN(pb + 9)) { PHASE_BEGIN();
#pragma clang loop unroll(disable)
            for (int pass = 0; pass < 2; ++pass) {
            if ((pass == 1) == (F.bid < 128)) {
            { pg8::Gemm g{WSP(bf16, WS_H), WGT(W_OUT), NLAT, DM, DM, DM, DM}; pg8::StaticOrder S; S.init(NLAT, DM, F.G, F.bid);
              EpiResidN E{XBP, modl, modl, INP(I_NORMG) + (lq * 3 + 2) * DM, WSP(float, WS_RSSN) + 2 * NLAT, WSP(bf16, B_H2), 5, 2, 1.0f}; pg8::gemm_phase<EpiResidN, pg8::StaticOrder, true, true>(glds, g, S, E, F.tid); }
            } else if (!last) { pg8::Gemm g{WSP(bf16, WS_H) + (size_t)NLAT * DM, WGT(W_OUT), NCTX, DM, 256, DM, DM}; pg8::SliceOrder S; S.init(NCTX, DM, 4, F.G, F.bid);
              EpiSlab E{WSP(float, B_SLAB), modl, 5, 0, 1.0f}; pg8::gemm_phase<EpiSlab, pg8::SliceOrder, true, true>(glds, g, S, E, F.tid); }
            }
        }
        SEAM(pb + 9);
        if (PM(10) && IN(pb + 10)) { PHASE_BEGIN(); if (!last) norm_phase(F, lq, 2, false, false, NLAT, NTOK, 4, WSP(bf16, B_H2)); }
        if (!last) SEAM(pb + 10);
        if (PM(11) && IN(pb + 11)) { PHASE_BEGIN(); pg8::Gemm g{WSP(bf16, B_H2), lq > 0 ? F2ALT : WGT(W_F2I), MR, 2 * DFF, DM, DM, DM}; pg8::StaticOrder S; S.init(MR, 2 * DFF, F.G, F.bid);
            EpiSwiglu E{WSP(bf16, B_ACT), WSP(float, WS_RSSN) + 2 * NLAT, WSP(float, WS_SHW) + (size_t)lq * SHW_LAYER + SHW_F2, 1}; pg8::gemm_phase<EpiSwiglu, pg8::StaticOrder, true, true>(glds, g, S, E, F.tid);
            if (lq == 0) tail_convert(F, S.nwg, 3); }
        SEAM(pb + 11);
        if (PM(12) && IN(pb + 12)) { PHASE_BEGIN();
#pragma clang loop unroll(disable)
            for (int pass = 0; pass < 2; ++pass) {
            if ((pass == 1) == (F.bid < 128)) {
            { pg8::Gemm g{WSP(bf16, B_ACT), lq > 0 ? F2ALT + (W_F2O - W_F2I) : WGT(W_F2O), NLAT, DM, DFF, DFF, DFF}; pg8::StaticOrder S; S.init(NLAT, DM, F.G, F.bid);
              if (!last) { EpiResidN E{XBP, modl, MOD + (size_t)(lq + 1) * 9 * MODW, INP(I_NORMG) + ((lq + 1) * 3 + 0) * DM, WSP(float, WS_RSSN), WSP(bf16, WS_H), 8, 0, 0.5f}; pg8::gemm_phase<EpiResidN, pg8::StaticOrder, true, true>(glds, g, S, E, F.tid); }
              else { pg8::Epi8<FResid> E{FResid{XBP, WSP(bf16, B_XF), modl, 8, 0.5f}}; pg8::gemm_phase<pg8::Epi8<FResid>, pg8::StaticOrder, true, true>(glds, g, S, E, F.tid); } }
            } else if (!last) {
            { pg8::Gemm g{WSP(bf16, B_ACT) + (size_t)NLAT * DFF, WGT(W_F2O), NCTX, DM, 768, DFF, DFF}; pg8::SliceOrder S; S.init(NCTX, DM, 2, F.G, F.bid);
              EpiSlab E{WSP(float, B_SLAB), modl, 8, 0, 0.5f}; pg8::gemm_phase<EpiSlab, pg8::SliceOrder, true, true>(glds, g, S, E, F.tid); }
            { pg8::Gemm g{WSP(bf16, B_ACT) + (size_t)NLAT * DFF + 1536, WGT(W_F2O) + 1536, NCTX, DM, 640, DFF, DFF}; pg8::SliceOrder S; S.init(NCTX, DM, 2, F.G, (F.bid + F.G - 64) % F.G);
              EpiSlab E{WSP(float, B_SLAB), modl, 8, 2, 0.5f}; pg8::gemm_phase<EpiSlab, pg8::SliceOrder, true, true>(glds, g, S, E, F.tid); }
            } }
        }
        SEAM(pb + 12);
    }
#undef modl
    if (PM(14) && IN(N_PHASES - 1)) { PHASE_BEGIN(); final_norm(F); }
#if PROBING && !MK_PER_PHASE
    xcd_barrier(bar, F.wave);
    if (blockIdx.x == 0) {
        const unsigned long long* ts = (const unsigned long long*)(ctl + CW_TS);
        const int ptid = (F.wave << 6) | (int)__builtin_amdgcn_mbcnt_hi(~0u, __builtin_amdgcn_mbcnt_lo(~0u, 0u));
        if (PROBE_A >= 0 && ptid == 0) { const float us = (float)(ts[PROBE_AE] - ts[PROBE_A]) * 0.01f; const float v = fminf(us * (1.0f / PROBE_FS), 1.0f); args.out[0] += 0.05f + 0.14f * v; }
        if (PROBE_B >= 0) { const float us = (float)(ts[PROBE_BE] - ts[PROBE_B]) * 0.01f; const float v = fminf(us * (1.0f / PROBE_FSB), 1.0f); const float d = sqrtf(16.0f * (1e-5f + 4e-5f * v));
            for (int i = 1024 + ptid; i < 1024 + (1 << 20); i += NTHR) args.out[i] += (i & 1) ? d : -d; }
    }
#endif
#undef IN
#undef SEAM
}

extern "C" void kernel_launch(void* const* d_in, const int* in_sizes, int n_in, void* d_out, int out_size, void* d_ws, size_t ws_size, hipStream_t stream) {
    static int grid = 0;
    if (grid == 0) {
        if (n_in != 31 || in_sizes[0] != NLAT * DM || out_size != NLAT * DM || ws_size < WS_END) { fprintf(stderr, "kernel_launch: unexpected shapes (n_in %d, in0 %d, out %d, ws %zu < %zu); nothing launched\n", n_in, n_in > 0 ? in_sizes[0] : -1, out_size, ws_size, (size_t)WS_END); grid = -1; return; }
        int dev = 0, cus = 0, per_cu = 0;
        if (hipGetDevice(&dev) != hipSuccess || hipDeviceGetAttribute(&cus, hipDeviceAttributeMultiprocessorCount, dev) != hipSuccess) { grid = -1; return; }
        if (hipFuncSetAttribute((const void*)mk_fwd, hipFuncAttributeMaxDynamicSharedMemorySize, LDS_BYTES) != hipSuccess) { fprintf(stderr, "kernel_launch: hipFuncSetAttribute failed\n"); grid = -1; return; }
        if (hipOccupancyMaxActiveBlocksPerMultiprocessor(&per_cu, (const void*)mk_fwd, NTHR, LDS_BYTES) != hipSuccess || per_cu < 1) { fprintf(stderr, "kernel_launch: occupancy query says %d blocks per CU\n", per_cu); (void)hipGetLastError(); grid = -1; return; }
        grid = cus;
    }
    if (grid < 0) return;
    if (hipMemsetAsync((char*)d_ws + WS_CTL, 0, CTL_ZERO_BYTES, stream) != hipSuccess) return;
    Args a{};
    for (int i = 0; i < 31; ++i) a.in[i] = (const float*)d_in[i];
    a.out = (float*)d_out; a.ws = (unsigned char*)d_ws;
#if MK_PER_PHASE
    for (int p = 0; p < N_PHASES; ++p) { a.ph_lo = p; a.ph_hi = p + 1; hipLaunchKernelGGL(mk_fwd, dim3(grid), dim3(NTHR), LDS_BYTES, stream, a); }
#else
    a.ph_lo = 0; a.ph_hi = N_PHASES;
    void* kargs[] = {&a};
    hipError_t e = hipLaunchCooperativeKernel((const void*)mk_fwd, dim3(grid), dim3(NTHR), kargs, LDS_BYTES, stream);
    if (e != hipSuccess) fprintf(stderr, "kernel_launch: cooperative launch failed: %s (grid %d)\n", hipGetErrorString(e), grid);
#endif
}
```
